# Optimizing an MI355X kernel written in HIP

```python
import math
import jax, jax.numpy as jnp
from jax import lax
import numpy as np

D_MODEL = 2048
BATCH = 4
SEQ = 2048
DEPTH = 1
DEC_BATCH = 32
DEC_SEQ = 64
PAST_LEN = 2048

CHUNK = 64
D_RNN = 1024
LRU_BLOCKS = 16
LRU_BLOCK = D_RNN // LRU_BLOCKS
CONV_W = 4
LRU_C = 8.0
RET_HEADS = 8
RET_DK = 128
RET_DV = 128
D_RET_K = RET_HEADS * RET_DK
D_RET_V = RET_HEADS * RET_DV
D_FF = 5632
DN_ALPHA = (2.0 * DEPTH) ** 0.25
DN_BETA = (8.0 * DEPTH) ** -0.25
LN_EPS = 1e-5
GN_EPS = 1e-5
ROPE_BASE = 10000.0
D_IN = 2 * D_RNN + 2 * D_RET_K + 2 * D_RET_V + 2 * D_MODEL
SPLIT_POINTS = (D_RNN, 2 * D_RNN, 2 * D_RNN + D_RET_K, 2 * D_RNN + 2 * D_RET_K,
                2 * D_RNN + 2 * D_RET_K + D_RET_V, 2 * D_RNN + 2 * D_RET_K + 2 * D_RET_V,
                2 * D_RNN + 2 * D_RET_K + 2 * D_RET_V + D_MODEL)

kernel_name = 'hawk_retnet_macaron_deepnorm_stream_step'


def layer_norm(x, g, b):
    xf = x.astype(jnp.float32)
    mu = jnp.mean(xf, -1, keepdims=True)
    var = jnp.mean(jnp.square(xf - mu), -1, keepdims=True)
    return ((xf - mu) * lax.rsqrt(var + LN_EPS) * g.astype(jnp.float32) + b.astype(jnp.float32)).astype(x.dtype)


def swiglu_ffn(x, w_gate, w_up, w_down):
    return (jax.nn.silu(x @ w_gate) * (x @ w_up)) @ w_down


def causal_dwconv(xb, conv_state, w, b):
    T = xb.shape[1]
    xpad = jnp.concatenate([conv_state.astype(xb.dtype), xb], axis=1)
    y = b
    for j in range(CONV_W):
        y = y + w[j] * xpad[:, j:j + T]
    return y, xpad[:, -(CONV_W - 1):]


def rg_lru(x, h0, rg_w, rg_b, ig_w, ig_b, lam):
    B, T, _ = x.shape
    xf = x.astype(jnp.float32)
    xg = xf.reshape(B, T, LRU_BLOCKS, LRU_BLOCK)
    r = jax.nn.sigmoid(jnp.einsum('btnk,nkj->btnj', xg, rg_w.astype(jnp.float32)).reshape(B, T, D_RNN) + rg_b)
    i = jax.nn.sigmoid(jnp.einsum('btnk,nkj->btnj', xg, ig_w.astype(jnp.float32)).reshape(B, T, D_RNN) + ig_b)
    log_a = -LRU_C * r * jax.nn.softplus(-lam.astype(jnp.float32))
    a = jnp.exp(log_a)
    u = jnp.sqrt(-jnp.expm1(2.0 * log_a)) * (i * xf)

    def combine(left, right):
        a1, b1 = left
        a2, b2 = right
        return a1 * a2, a2 * b1 + b2

    A, Bc = lax.associative_scan(combine, (a, u), axis=1)
    h = A * h0.astype(jnp.float32)[:, None] + Bc
    return h, h[:, -1]


def rotary(x, pos):
    d = x.shape[-1]
    inv_freq = ROPE_BASE ** (-jnp.arange(0, d, 2, dtype=jnp.float32) / d)
    ang = pos.astype(jnp.float32)[:, None] * inv_freq[None, :]
    cos = jnp.cos(ang)[None, :, None, :]
    sin = jnp.sin(ang)[None, :, None, :]
    x1, x2 = x[..., : d // 2], x[..., d // 2:]
    return jnp.concatenate([x1 * cos - x2 * sin, x1 * sin + x2 * cos], axis=-1)


def retention_chunkwise(q, k, v, S0):
    B, T, H, DK = q.shape
    DV = v.shape[-1]
    C = min(CHUNK, T)
    n = T // C
    log_g = jnp.log1p(-jnp.exp2(-5.0 - jnp.arange(H, dtype=jnp.float32)))
    idx = jnp.arange(C, dtype=jnp.float32)
    diff = idx[:, None] - idx[None, :]
    dmask = jnp.where(diff >= 0, jnp.exp(log_g[:, None, None] * jnp.maximum(diff, 0.0)), 0.0)
    q_dec = jnp.exp(log_g[:, None] * (idx[None, :] + 1.0)).T[None, :, :, None]
    k_dec = jnp.exp(log_g[:, None] * (C - 1.0 - idx[None, :])).T[None, :, :, None]
    chunk_dec = jnp.exp(log_g * C)[None, :, None, None]

    def to_chunks(t):
        return jnp.moveaxis(t.reshape(B, n, C, H, t.shape[-1]), 1, 0)

    def step(S, inp):
        qi, ki, vi = inp
        s = jnp.einsum('bihd,bjhd->bhij', qi, ki) * dmask
        o = jnp.einsum('bhij,bjhe->bihe', s, vi) + jnp.einsum('bihd,bhde->bihe', qi * q_dec, S)
        S = chunk_dec * S + jnp.einsum('bjhd,bjhe->bhde', ki * k_dec, vi)
        return S, o

    S, o = lax.scan(step, S0, (to_chunks(q), to_chunks(k), to_chunks(v)))
    return jnp.moveaxis(o, 0, 1).reshape(B, T, H, DV), S


def trunk_layer(x, pos, conv0, h0, S0,
                f1_g, f1_u, f1_d, ln1_g, ln1_b,
                w_in, conv_w, conv_b, rg_w, rg_b, ig_w, ig_b, lam,
                gn_g, gn_b, w_a_proj, w_b_proj, w_o, ln2_g, ln2_b,
                f2_g, f2_u, f2_d, ln3_g, ln3_b):
    B, T, _ = x.shape
    x = layer_norm(DN_ALPHA * x + 0.5 * swiglu_ffn(x, f1_g, f1_u, f1_d), ln1_g, ln1_b)

    z = x @ w_in
    xa, ga, q, k, v, g, gate_a, gate_b = jnp.split(z, list(SPLIT_POINTS), axis=-1)

    xc, conv_new = causal_dwconv(xa, conv0, conv_w, conv_b)
    h, h_last = rg_lru(xc, h0, rg_w, rg_b, ig_w, ig_b, lam)
    ya = (h * jax.nn.gelu(ga.astype(jnp.float32))).astype(x.dtype)

    qh = rotary(q.reshape(B, T, RET_HEADS, RET_DK).astype(jnp.float32), pos)
    kh = rotary(k.reshape(B, T, RET_HEADS, RET_DK).astype(jnp.float32), pos) * (RET_DK ** -0.5)
    vh = v.reshape(B, T, RET_HEADS, RET_DV).astype(jnp.float32)
    o, S_new = retention_chunkwise(qh, kh, vh, S0.astype(jnp.float32))
    mu = jnp.mean(o, -1, keepdims=True)
    var = jnp.mean(jnp.square(o - mu), -1, keepdims=True)
    o = ((o - mu) * lax.rsqrt(var + GN_EPS)).reshape(B, T, D_RET_V) * gn_g.astype(jnp.float32) + gn_b.astype(jnp.float32)
    yb = (jax.nn.silu(g.astype(jnp.float32)) * o).astype(x.dtype)

    merged = jax.nn.sigmoid(gate_a) * (ya @ w_a_proj) + jax.nn.sigmoid(gate_b) * (yb @ w_b_proj)
    x = layer_norm(DN_ALPHA * x + merged @ w_o, ln2_g, ln2_b)

    x = layer_norm(DN_ALPHA * x + 0.5 * swiglu_ffn(x, f2_g, f2_u, f2_d), ln3_g, ln3_b)
    return x, conv_new, h_last, S_new


def setup_inputs(seed: int = 0) -> dict:
    key = jax.random.key(seed)
    ks = jax.random.split(key, 32)
    f32 = jnp.float32
    L = DEPTH

    def nrm(k, shape, scale):
        return jax.random.normal(k, shape, f32) * scale

    u = jax.random.uniform(ks[13], (L, D_RNN), f32, 0.9, 0.999)
    s = u ** (1.0 / LRU_C)
    lru_lambda = jnp.log(s) - jnp.log1p(-s)
    return {
        'x_prompt': nrm(ks[0], (BATCH, SEQ, D_MODEL), 1.0),
        'x_sample': nrm(ks[1], (DEC_BATCH, DEC_SEQ, D_MODEL), 1.0),
        'state_conv': nrm(ks[2], (L, DEC_BATCH, CONV_W - 1, D_RNN), 1.0),
        'state_lru': nrm(ks[3], (L, DEC_BATCH, D_RNN), 0.5),
        'state_ret': nrm(ks[4], (L, DEC_BATCH, RET_HEADS, RET_DK, RET_DV), 0.5),
        'ffn1_w_gate': nrm(ks[5], (L, D_MODEL, D_FF), D_MODEL ** -0.5),
        'ffn1_w_up': nrm(ks[6], (L, D_MODEL, D_FF), D_MODEL ** -0.5),
        'ffn1_w_down': nrm(ks[7], (L, D_FF, D_MODEL), DN_BETA * D_FF ** -0.5),
        'ln1_g': 1.0 + nrm(ks[8], (L, D_MODEL), 0.02),
        'ln1_b': nrm(ks[9], (L, D_MODEL), 0.02),
        'w_in': nrm(ks[10], (L, D_MODEL, D_IN), D_MODEL ** -0.5),
        'conv_w': nrm(ks[11], (L, CONV_W, D_RNN), CONV_W ** -0.5),
        'conv_b': nrm(ks[12], (L, D_RNN), 0.02),
        'rg_w': nrm(ks[14], (L, LRU_BLOCKS, LRU_BLOCK, LRU_BLOCK), LRU_BLOCK ** -0.5),
        'rg_b': nrm(ks[15], (L, D_RNN), 0.02),
        'ig_w': nrm(ks[16], (L, LRU_BLOCKS, LRU_BLOCK, LRU_BLOCK), LRU_BLOCK ** -0.5),
        'ig_b': nrm(ks[17], (L, D_RNN), 0.02),
        'lru_lambda': lru_lambda,
        'ret_gn_g': 1.0 + nrm(ks[18], (L, D_RET_V), 0.02),
        'ret_gn_b': nrm(ks[19], (L, D_RET_V), 0.02),
        'w_a_proj': nrm(ks[20], (L, D_RNN, D_MODEL), D_RNN ** -0.5),
        'w_b_proj': nrm(ks[21], (L, D_RET_V, D_MODEL), D_RET_V ** -0.5),
        'w_o': nrm(ks[22], (L, D_MODEL, D_MODEL), DN_BETA * D_MODEL ** -0.5),
        'ln2_g': 1.0 + nrm(ks[23], (L, D_MODEL), 0.02),
        'ln2_b': nrm(ks[24], (L, D_MODEL), 0.02),
        'ffn2_w_gate': nrm(ks[25], (L, D_MODEL, D_FF), D_MODEL ** -0.5),
        'ffn2_w_up': nrm(ks[26], (L, D_MODEL, D_FF), D_MODEL ** -0.5),
        'ffn2_w_down': nrm(ks[27], (L, D_FF, D_MODEL), DN_BETA * D_FF ** -0.5),
        'ln3_g': 1.0 + nrm(ks[28], (L, D_MODEL), 0.02),
        'ln3_b': nrm(ks[29], (L, D_MODEL), 0.02),
    }


def reference(x_prompt, x_sample, state_conv, state_lru, state_ret,
              ffn1_w_gate, ffn1_w_up, ffn1_w_down, ln1_g, ln1_b,
              w_in, conv_w, conv_b, rg_w, rg_b, ig_w, ig_b, lru_lambda,
              ret_gn_g, ret_gn_b, w_a_proj, w_b_proj, w_o, ln2_g, ln2_b,
              ffn2_w_gate, ffn2_w_up, ffn2_w_down, ln3_g, ln3_b):

    def run(x, pos, conv0, h0, S0):
        convs, hs, Ss = [], [], []
        for l in range(DEPTH):
            x, c, h, S = trunk_layer(
                x, pos, conv0[l], h0[l], S0[l],
                ffn1_w_gate[l], ffn1_w_up[l], ffn1_w_down[l], ln1_g[l], ln1_b[l],
                w_in[l], conv_w[l], conv_b[l], rg_w[l], rg_b[l], ig_w[l], ig_b[l], lru_lambda[l],
                ret_gn_g[l], ret_gn_b[l], w_a_proj[l], w_b_proj[l], w_o[l], ln2_g[l], ln2_b[l],
                ffn2_w_gate[l], ffn2_w_up[l], ffn2_w_down[l], ln3_g[l], ln3_b[l])
            convs.append(c.astype(state_conv.dtype))
            hs.append(h.astype(state_lru.dtype))
            Ss.append(S.astype(state_ret.dtype))
        return x, jnp.stack(convs), jnp.stack(hs), jnp.stack(Ss)

    Bp, Tp, _ = x_prompt.shape
    pos_p = jnp.arange(Tp, dtype=jnp.int32)
    conv0_p = jnp.zeros((DEPTH, Bp, CONV_W - 1, D_RNN), state_conv.dtype)
    h0_p = jnp.zeros((DEPTH, Bp, D_RNN), state_lru.dtype)
    S0_p = jnp.zeros((DEPTH, Bp, RET_HEADS, RET_DK, RET_DV), state_ret.dtype)
    y_prompt, conv_prompt, lru_prompt, ret_prompt = run(x_prompt, pos_p, conv0_p, h0_p, S0_p)

    Ts = x_sample.shape[1]
    pos_s = PAST_LEN + jnp.arange(Ts, dtype=jnp.int32)
    y_sample, conv_sample, lru_sample, ret_sample = run(x_sample, pos_s, state_conv, state_lru, state_ret)

    return (y_prompt, y_sample, conv_prompt, lru_prompt, ret_prompt, conv_sample, lru_sample, ret_sample)
```

```cpp
#include <hip/hip_runtime.h>
#include <hip/hip_cooperative_groups.h>
#include <cstdio>
#include <cstdint>
namespace cg = cooperative_groups;
namespace pg8 {
#define PG8_LAS __attribute__((address_space(3)))
typedef unsigned short bf16_t;
typedef short bf16x8 __attribute__((ext_vector_type(8)));
typedef float f32x4 __attribute__((ext_vector_type(4)));
typedef unsigned u32x4 __attribute__((ext_vector_type(4)));
constexpr int BM = 256, BK = 64, HALF = 128, HTB = HALF * BK * 2  , STAGE_BYTES = 8 * HTB, NXCD = 8, WGM = 4;

__host__ __device__ __forceinline__ int lds_byte(int r, int c) { const int st = (r >> 4) * 2 + (c >> 5), rr = r & 15, cc = c & 31, ob = rr * 64 + cc * 2; return st * 1024 + (ob ^ (((ob >> 9) & 1) << 5)); }
__host__ __device__ __forceinline__ void stage_rc(int b, int& R, int& C) { const int st = b / 1024, sb = b % 1024, swz = sb ^ (((sb >> 9) & 1) << 5); R = (st >> 1) * 16 + swz / 64; C = (st & 1) * 32 + (swz % 64) / 2; }
__host__ __device__ __forceinline__ int perm32(int rho) { const int n = rho >> 4, i = rho & 15; return 8 * (i >> 2) + 4 * n + (i & 3); }

struct Unit { int pm, pn, kt0, nkt, pidx; };
struct Gemm { const bf16_t* A; const bf16_t* Bt; int M, N, K; };

struct StaticOrder {
    int nM, nN, nwg, G, c, ntk;
    __host__ __device__ void init(int M, int N, int G_, int c_, int K_) { nM = M / BM; nN = N / BM; nwg = nM * nN; G = G_; c = c_; ntk = K_ / BK; }
    __host__ __device__ bool next(int i, Unit& u) const {
        const long L = (long)i * G + c; if (L >= nwg) return false;
        int wgid = (int)L; { const int q = nwg / NXCD, r = nwg % NXCD, xcd = wgid % NXCD, off = wgid / NXCD; wgid = (xcd < r ? xcd * (q + 1) : r * (q + 1) + (xcd - r) * q) + off; }
        const int nig = WGM * nN, gid = wgid / nig, fm = gid * WGM, gsz = (nM - fm) < WGM ? (nM - fm) : WGM;
        u.pm = fm + ((wgid % nig) % gsz); u.pn = (wgid % nig) / gsz; u.kt0 = 0; u.nkt = ntk; u.pidx = -1; return true;
    }
    __device__ __forceinline__ void a_ready(const Unit&) const {}
    __device__ __forceinline__ void done(const Unit&) const {}
};

struct TailSplitOrder {
    int nN, ntu, G, v, R, nT, split;
    __host__ __device__ void init(int M, int N, int K, int G_, int v_) {
        nN = N / BM; ntu = K / BK; G = G_; v = v_; const int nu = (M / BM) * nN; R = nu / G; nT = nu - R * G; split = 1;
        if (nT > 0 && G % nT == 0 && ntu % (G / nT) == 0 && ((ntu / (G / nT)) & 1) == 0 && ntu / (G / nT) >= 4) split = G / nT;
    }
    __host__ __device__ int tail_pm0() const { return (R * G) / nN; }
    __host__ __device__ bool next(int i, Unit& u) const {
        if (i < R) { const int t = i * G + v; u.pm = t / nN; u.pn = t - u.pm * nN; u.kt0 = 0; u.nkt = ntu; u.pidx = -1; return true; }
        if (i > R || nT == 0) return false;
        if (split == 1) { if (v >= nT) return false; const int t = R * G + v; u.pm = t / nN; u.pn = t - u.pm * nN; u.kt0 = 0; u.nkt = ntu; u.pidx = -1; return true; }
        const int pn = v % nN, q = (v / nN) % split, pl = v / (nN * split), l = pl * nN + pn, t = R * G + l;
        u.pm = t / nN; u.pn = t - u.pm * nN; u.nkt = ntu / split; u.kt0 = q * u.nkt; u.pidx = q == 0 ? -1 : l * (split - 1) + q - 1; return true;
    }
    __device__ __forceinline__ void a_ready(const Unit&) const {}
    __device__ __forceinline__ void done(const Unit&) const {}
};

__device__ __forceinline__ unsigned cvt_pk_bf16(float lo, float hi) { unsigned r; asm volatile("v_cvt_pk_bf16_f32 %0, %1, %2" : "=v"(r) : "v"(lo), "v"(hi)); return r; }
typedef float f32x2 __attribute__((ext_vector_type(2)));
template <class Epi, class Sched, bool ALIGN_EPI = false, bool SP2 = false>
__device__ __forceinline__ void gemm_phase(PG8_LAS unsigned char* lds, const Gemm g, const Sched& S, const Epi& E) {
    int tid_ = threadIdx.x; asm volatile("" : "+v"(tid_));
    const int tid = tid_, wid = __builtin_amdgcn_readfirstlane(tid >> 6), lane = tid & 63, wr = wid >> 2, wc = wid & 3, fr = lane & 15, fq = lane >> 4;
    const int K = g.K, nt = K / BK;
    unsigned voffA[2], voffB[2];
#pragma unroll
    for (int i = 0; i < 2; ++i) { int R, C; stage_rc(tid * 16 + i * 8192, R, C); const int Rb = Epi::PERM ? ((R & ~31) + perm32(R & 31)) : R;
        voffA[i] = (unsigned)(R * K + C) * 2u; voffB[i] = (unsigned)(Rb * K + C) * 2u; }
    const size_t kstep = (size_t)(BK * 2);
    const size_t hstep = (size_t)HALF * K * 2;
    const size_t tstep = 2 * hstep;
    const unsigned ldsw = (unsigned)wid * 1024u;
    const int aoff = lds_byte(wr * 64 + fr, fq * 8), boff = lds_byte(wc * 32 + fr, fq * 8);
#define PG8_SA(b, h) (((b) * 2 + (h)) * HTB)
#define PG8_SB(b, h) ((4 + (b) * 2 + (h)) * HTB)
#define PG8_STAGE(bufoff, gbase, voff) do { _Pragma("unroll") for (int _i = 0; _i < 2; ++_i) \
        __builtin_amdgcn_global_load_lds((const unsigned*)((const char*)(gbase) + (voff)[_i]), (PG8_LAS unsigned*)(lds + (bufoff) + ldsw + _i * 8192), 16, 0, 0); } while (0)
#define PG8_LDA(dst, b, h) do { _Pragma("unroll") for (int m = 0; m < 4; ++m) _Pragma("unroll") for (int k = 0; k < 2; ++k) dst[m][k] = *(const PG8_LAS bf16x8*)(lds + PG8_SA(b, h) + aoff + m * 2048 + k * 1024); } while (0)
#define PG8_LDB(dst, b, h) do { _Pragma("unroll") for (int n = 0; n < 2; ++n) _Pragma("unroll") for (int k = 0; k < 2; ++k) dst[n][k] = *(const PG8_LAS bf16x8*)(lds + PG8_SB(b, h) + boff + n * 2048 + k * 1024); } while (0)
#define PG8_MMA(ai, bj, At, Bt) do { __builtin_amdgcn_s_setprio(1); _Pragma("unroll") for (int m = 0; m < 4; ++m) _Pragma("unroll") for (int n = 0; n < 2; ++n) _Pragma("unroll") for (int k = 0; k < 2; ++k) \
        acc[ai][bj][m][n] = __builtin_amdgcn_mfma_f32_16x16x32_bf16(Bt[n][k], At[m][k], acc[ai][bj][m][n], 0, 0, 0); __builtin_amdgcn_s_setprio(0); } while (0)
#define PG8_WAIT_V(n) asm volatile("s_waitcnt vmcnt(" #n ")" ::: "memory")
#define PG8_WAIT_L(n) asm volatile("s_waitcnt lgkmcnt(" #n ")" ::: "memory")
#define PG8_BAR __builtin_amdgcn_s_barrier()
#define PG8_SCHED __builtin_amdgcn_sched_barrier(0)
    Unit cur, nxt; int ui = 0;
    if (!S.next(0, cur)) return;
    f32x4 acc[2][2][4][2];
#pragma unroll
    for (int a = 0; a < 2; ++a)
#pragma unroll
        for (int b = 0; b < 2; ++b)
#pragma unroll
            for (int m = 0; m < 4; ++m)
#pragma unroll
                for (int n = 0; n < 2; ++n) acc[a][b][m][n] = (f32x4){0.f, 0.f, 0.f, 0.f};
    bf16x8 At[4][2], B0[2][2], B1[2][2];
    const char* cA = (const char*)g.A + (size_t)cur.pm * tstep + (size_t)cur.kt0 * kstep; const char* cB = (const char*)g.Bt + (size_t)cur.pn * tstep + (size_t)cur.kt0 * kstep;
    S.a_ready(cur);
    if constexpr (SP2) {
        PG8_STAGE(PG8_SB(0, 0), cB, voffB); PG8_STAGE(PG8_SB(0, 1), cB + hstep, voffB); PG8_STAGE(PG8_SA(0, 0), cA, voffA); PG8_STAGE(PG8_SA(0, 1), cA + hstep, voffA);
        if (wr == 1) PG8_BAR;
        PG8_WAIT_V(2); PG8_BAR;
        PG8_STAGE(PG8_SB(1, 0), cB + kstep, voffB); PG8_STAGE(PG8_SA(1, 0), cA + kstep, voffA); PG8_STAGE(PG8_SB(1, 1), cB + hstep + kstep, voffB);
        PG8_WAIT_V(6); PG8_BAR;
    } else {
        PG8_STAGE(PG8_SB(0, 0), cB, voffB); PG8_STAGE(PG8_SA(0, 0), cA, voffA); PG8_STAGE(PG8_SB(0, 1), cB + hstep, voffB); PG8_STAGE(PG8_SA(0, 1), cA + hstep, voffA);
        if (wr == 1) PG8_BAR;
        PG8_WAIT_V(4); PG8_BAR;
        PG8_STAGE(PG8_SB(1, 0), cB + kstep, voffB); PG8_STAGE(PG8_SA(1, 0), cA + kstep, voffA); PG8_STAGE(PG8_SB(1, 1), cB + hstep + kstep, voffB);
        PG8_WAIT_V(6); PG8_BAR;
    }
    for (;;) {
        const bool has_next = S.next(ui + 1, nxt);
        const char* nA = has_next ? (const char*)g.A + (size_t)nxt.pm * tstep + (size_t)nxt.kt0 * kstep : cA; const char* nB = has_next ? (const char*)g.Bt + (size_t)nxt.pn * tstep + (size_t)nxt.kt0 * kstep : cB;
        const int cnt = cur.nkt;
        for (int t = 0; t < cnt; t += 2) {
            const bool last = (t == cnt - 2);
            const char* a1 = cA + (size_t)(t + 1) * kstep;
            const char* a2 = last ? nA : cA + (size_t)(t + 2) * kstep; const char* b2 = last ? nB : cB + (size_t)(t + 2) * kstep;
            const char* a3 = a2 + kstep; const char* b3 = b2 + kstep;
            if (last && has_next) S.a_ready(nxt);
            if constexpr (Epi::HAS_MID) { if (t == (nt >> 1)) E.mid(acc, cur, wr, wc, fr, fq); }
            if constexpr (SP2) {
            PG8_LDB(B0, 0, 0); PG8_LDB(B1, 0, 1); PG8_SCHED; PG8_LDA(At, 0, 0); PG8_STAGE(PG8_SA(1, 1), a1 + hstep, voffA);
            PG8_WAIT_V(8); PG8_WAIT_L(0); PG8_BAR; PG8_MMA(0, 0, At, B0); PG8_MMA(0, 1, At, B1); PG8_BAR; PG8_SCHED;
            PG8_LDA(At, 0, 1); PG8_STAGE(PG8_SB(0, 0), b2, voffB); PG8_STAGE(PG8_SB(0, 1), b2 + hstep, voffB); PG8_STAGE(PG8_SA(0, 0), a2, voffA);
            PG8_WAIT_V(8); PG8_WAIT_L(0); PG8_BAR; PG8_MMA(1, 0, At, B0); PG8_MMA(1, 1, At, B1); PG8_BAR; PG8_SCHED;
            PG8_LDB(B0, 1, 0); PG8_LDB(B1, 1, 1); PG8_SCHED; PG8_LDA(At, 1, 0); PG8_STAGE(PG8_SA(0, 1), a2 + hstep, voffA);
            PG8_WAIT_V(8); PG8_WAIT_L(0); PG8_BAR; PG8_MMA(0, 0, At, B0); PG8_MMA(0, 1, At, B1); PG8_BAR; PG8_SCHED;
            PG8_LDA(At, 1, 1); PG8_STAGE(PG8_SB(1, 0), b3, voffB); PG8_STAGE(PG8_SB(1, 1), b3 + hstep, voffB); PG8_STAGE(PG8_SA(1, 0), a3, voffA);
            PG8_WAIT_V(8); PG8_WAIT_L(0); PG8_BAR; PG8_MMA(1, 0, At, B0); PG8_MMA(1, 1, At, B1); PG8_BAR; PG8_SCHED;
            } else {
            PG8_LDB(B0, 0, 0); PG8_SCHED; PG8_LDA(At, 0, 0); PG8_STAGE(PG8_SA(1, 1), a1 + hstep, voffA);
            PG8_WAIT_L(8); PG8_BAR; PG8_WAIT_L(0); PG8_MMA(0, 0, At, B0); PG8_BAR; PG8_SCHED;
            PG8_LDB(B1, 0, 1); PG8_STAGE(PG8_SB(0, 0), b2, voffB);
            PG8_BAR; PG8_WAIT_L(0); PG8_MMA(0, 1, At, B1); PG8_BAR;
            PG8_LDA(At, 0, 1); PG8_STAGE(PG8_SA(0, 0), a2, voffA);
            PG8_BAR; PG8_WAIT_L(0); PG8_MMA(1, 0, At, B0); PG8_BAR; PG8_SCHED;
            PG8_STAGE(PG8_SB(0, 1), b2 + hstep, voffB);
            PG8_WAIT_V(6); PG8_BAR; PG8_MMA(1, 1, At, B1); PG8_BAR;
            PG8_LDB(B0, 1, 0); PG8_SCHED; PG8_LDA(At, 1, 0); PG8_STAGE(PG8_SA(0, 1), a2 + hstep, voffA);
            PG8_WAIT_L(8); PG8_BAR; PG8_WAIT_L(0); PG8_MMA(0, 0, At, B0); PG8_BAR; PG8_SCHED;
            PG8_LDB(B1, 1, 1); PG8_STAGE(PG8_SB(1, 0), b3, voffB);
            PG8_BAR; PG8_WAIT_L(0); PG8_MMA(0, 1, At, B1); PG8_BAR;
            PG8_LDA(At, 1, 1); PG8_STAGE(PG8_SA(1, 0), a3, voffA);
            PG8_BAR; PG8_WAIT_L(0); PG8_MMA(1, 0, At, B0); PG8_BAR; PG8_SCHED;
            PG8_STAGE(PG8_SB(1, 1), b3 + hstep, voffB);
            PG8_WAIT_V(6); PG8_BAR; PG8_MMA(1, 1, At, B1); PG8_BAR;
            }
        }
        if constexpr (ALIGN_EPI) { if (wr == 0) PG8_BAR; }
        if constexpr (!Epi::AFTER_DRAIN) { E(acc, cur, wr, wc, fr, fq); S.done(cur); }
        if (!has_next) break;
#pragma unroll
        for (int a = 0; a < 2; ++a)
#pragma unroll
            for (int b = 0; b < 2; ++b)
#pragma unroll
                for (int m = 0; m < 4; ++m)
#pragma unroll
                    for (int n = 0; n < 2; ++n) acc[a][b][m][n] = (f32x4){0.f, 0.f, 0.f, 0.f};
        cur = nxt; cA = nA; cB = nB; ++ui;
        if constexpr (ALIGN_EPI) { if (wr == 1) PG8_BAR; }
    }
    PG8_WAIT_V(0);
    if constexpr (!ALIGN_EPI) { if (wr == 0) PG8_BAR; }
    PG8_BAR;
    if constexpr (Epi::AFTER_DRAIN) { E.fused(acc, cur, wr, wc, fr, fq, lds, wid, lane); S.done(cur); }
#undef PG8_SA
#undef PG8_SB
#undef PG8_STAGE
#undef PG8_LDA
#undef PG8_LDB
#undef PG8_MMA
#undef PG8_WAIT_V
#undef PG8_WAIT_L
#undef PG8_BAR
#undef PG8_SCHED
}
}

#define LAS __attribute__((address_space(3)))
typedef unsigned short bf16;
typedef short bf16x8 __attribute__((ext_vector_type(8)));
typedef float f32x4 __attribute__((ext_vector_type(4)));
typedef float f32x2 __attribute__((ext_vector_type(2)));
typedef unsigned u32x4 __attribute__((ext_vector_type(4)));
typedef unsigned u32x2 __attribute__((ext_vector_type(2)));

constexpr int DM = 2048, DFF = 5632, DRNN = 1024, NHEAD = 8;
constexpr int MP = 8192, MS = 2048, MT = MP + MS;
constexpr int SEQ = 2048, DSEQ = 64, NB = 4, NSB = 32;
constexpr int ZM_LD = 6144, ZG_LD = 4096;
constexpr float DN_ALPHA = 1.189207115002721f;
constexpr int NPOS = 2112;
constexpr int NWAVES = 8, NTHREADS = 512;
constexpr int LDS_BYTES = 147456;

constexpr size_t WS_TAB = 65536;
constexpr size_t WS_GATEW = WS_TAB + 1310720;
constexpr size_t WS_WGU = WS_GATEW + 262144;
constexpr size_t WS_WD = WS_WGU + (size_t)2 * DFF * DM * 2;
constexpr size_t WS_WIN = WS_WD + (size_t)DM * DFF * 2;
constexpr size_t WS_WAB = WS_WIN + (size_t)10240 * DM * 2;
constexpr size_t WS_WO = WS_WAB + (size_t)DM * DM * 2;
constexpr size_t WS_XNB = WS_WO + (size_t)DM * DM * 2;
constexpr size_t WS_X1 = WS_XNB + (size_t)MT * DM * 2;
constexpr size_t WS_H = WS_X1 + (size_t)MT * DM * 4;
constexpr size_t WS_T = WS_H + (size_t)MT * ZM_LD * 2;
constexpr size_t WS_END = WS_T + (size_t)MT * DM * 4;
static_assert(WS_WIN + (size_t)MT * DM * 4 <= WS_X1, "stream-K second buffer of the last down GEMM");
static_assert(WS_WGU + ((size_t)MT * DRNN + (size_t)NB * NHEAD * 8 * 16384 + (size_t)360 * DRNN * 2) * 4 <= WS_WIN, "mixer scratch fits the FFN weight region");
static_assert(1081344 + (size_t)MT * 2 * 4 * 2 <= 1310720, "row statistics fit behind the rotary table");
static_assert(WS_END <= 496066560, "workspace map exceeds the guaranteed ws_size");

constexpr size_t O_Y = 0;
constexpr size_t O_CONVP = (size_t)MT * DM;
constexpr size_t O_LRUP = O_CONVP + (size_t)NB * 3 * DRNN;
constexpr size_t O_RETP = O_LRUP + (size_t)NB * DRNN;
constexpr size_t O_CONVS = O_RETP + (size_t)NB * NHEAD * 16384;
constexpr size_t O_LRUS = O_CONVS + (size_t)NSB * 3 * DRNN;
constexpr size_t O_RETS = O_LRUS + (size_t)NSB * DRNN;

__device__ __forceinline__ float bflo(unsigned w) { return __uint_as_float(w << 16); }
__device__ __forceinline__ float bfhi(unsigned w) { return __uint_as_float(w & 0xffff0000u); }
__device__ __forceinline__ float bf2f(bf16 b) { return __uint_as_float((unsigned)b << 16); }
__device__ __forceinline__ unsigned f2bf(float f) { unsigned u = __float_as_uint(f); return (u + 0x7fffu + ((u >> 16) & 1u)) >> 16; }
__device__ __forceinline__ unsigned pk2(float lo, float hi) { return pg8::cvt_pk_bf16(lo, hi); }
__device__ __forceinline__ float fast_exp(float x) { return __builtin_amdgcn_exp2f(x * 1.4426950408889634f); }
__device__ __forceinline__ float fast_sigmoid(float x) { return __builtin_amdgcn_rcpf(1.0f + fast_exp(-x)); }
__device__ __forceinline__ float wave_sum(float v) {
#pragma unroll
    for (int o = 1; o < 64; o <<= 1) v += __shfl_xor(v, o);
    return v;
}
#define MFMA16(a, b, c) __builtin_amdgcn_mfma_f32_16x16x32_bf16((a), (b), (c), 0, 0, 0)

struct EpiSwiglu {
    static constexpr bool PERM = true, AFTER_DRAIN = false, HAS_MID = false;
    bf16* H;
    __device__ __forceinline__ void mid(f32x4 (&)[2][2][4][2], const pg8::Unit&, int, int, int, int) const {}
    __device__ __forceinline__ void operator()(const f32x4 (&acc)[2][2][4][2], const pg8::Unit& u, int wr, int wc, int fr, int fq) const {
        const int row0 = u.pm * 256 + wr * 64 + fr, col0 = u.pn * 128 + wc * 32 + 8 * fq;
#pragma unroll
        for (int ai = 0; ai < 2; ++ai)
#pragma unroll
            for (int m = 0; m < 4; ++m) {
                bf16* rowp = H + (size_t)(row0 + ai * 128 + m * 16) * DFF + col0;
                float v[8];
#pragma unroll
                for (int n = 0; n < 2; ++n)
#pragma unroll
                    for (int j = 0; j < 4; ++j) { const float g = acc[ai][0][m][n][j], up = acc[ai][1][m][n][j]; v[n * 4 + j] = g * fast_sigmoid(g) * up; }
                u32x4 w; w.x = pk2(v[0], v[1]); w.y = pk2(v[2], v[3]); w.z = pk2(v[4], v[5]); w.w = pk2(v[6], v[7]);
                *(u32x4*)rowp = w;
            }
    }
};
template <bool LNRES, bool HALFS> struct EpiRes {
    static constexpr bool PERM = true, AFTER_DRAIN = false, HAS_MID = false;
    const bf16* RB;
    bf16* T; bf16* P; const float* st; const float* lg; const float* lb;
    __device__ __forceinline__ void mid(f32x4 (&)[2][2][4][2], const pg8::Unit&, int, int, int, int) const {}
    __device__ __forceinline__ void operator()(const f32x4 (&acc)[2][2][4][2], const pg8::Unit& u, int wr, int wc, int fr, int fq) const {
        asm volatile("" : "+v"(fr));
        const int row0 = u.pm * 256 + wr * 64 + fr, col0 = u.pn * 256 + wc * 32 + 8 * fq;
        constexpr float alpha = DN_ALPHA, scale = HALFS ? 0.5f : 1.0f;
        constexpr int NG = 4;
        f32x4 gv[2][2], bv[2][2];
        if constexpr (LNRES) {
            const float* lgp = lg + col0; const float* lbp = lb + col0;
            asm volatile("" : "+v"(lgp), "+v"(lbp));
#pragma unroll
            for (int bj = 0; bj < 2; ++bj)
#pragma unroll
                for (int n = 0; n < 2; ++n) { gv[bj][n] = *(const f32x4*)(lgp + bj * 128 + n * 4); bv[bj][n] = *(const f32x4*)(lbp + bj * 128 + n * 4); }
        }
#pragma unroll
        for (int ai = 0; ai < 2; ++ai)
#pragma unroll
            for (int mp = 0; mp < 4 / NG; ++mp) {
                if (u.pidx >= 0) {
#pragma unroll
                    for (int mq = 0; mq < NG; ++mq)
#pragma unroll
                        for (int bj = 0; bj < 2; ++bj) { const int m = mp * NG + mq; const f32x4 o0 = acc[ai][bj][m][0] * scale, o1 = acc[ai][bj][m][1] * scale;
                            u32x4 w; w.x = pk2(o0.x, o0.y); w.y = pk2(o0.z, o0.w); w.z = pk2(o1.x, o1.y); w.w = pk2(o1.z, o1.w);
                            *(u32x4*)(P + (size_t)u.pidx * 65536 + (size_t)(wr * 64 + fr + ai * 128 + m * 16) * 256 + wc * 32 + 8 * fq + bj * 128) = w; }
                } else {
                    u32x4 rb[NG][2]; f32x2 ms[NG];
#pragma unroll
                    for (int mq = 0; mq < NG; ++mq) { const int m = mp * NG + mq; const size_t off = (size_t)(row0 + ai * 128 + m * 16) * DM + col0;
                        if constexpr (LNRES) ms[mq] = *(const f32x2*)(st + (size_t)(row0 + ai * 128 + m * 16) * 2);
#pragma unroll
                        for (int bj = 0; bj < 2; ++bj) rb[mq][bj] = *(const u32x4*)(RB + off + bj * 128); }
#pragma unroll
                    for (int mq = 0; mq < NG; ++mq) { const int m = mp * NG + mq; const size_t off = (size_t)(row0 + ai * 128 + m * 16) * DM + col0;
#pragma unroll
                        for (int bj = 0; bj < 2; ++bj) { const u32x4 q = rb[mq][bj];
                            f32x4 x0 = (f32x4){bflo(q.x), bfhi(q.x), bflo(q.y), bfhi(q.y)}, x1 = (f32x4){bflo(q.z), bfhi(q.z), bflo(q.w), bfhi(q.w)};
                            if constexpr (LNRES) { x0 = (x0 - ms[mq].x) * ms[mq].y * gv[bj][0] + bv[bj][0]; x1 = (x1 - ms[mq].x) * ms[mq].y * gv[bj][1] + bv[bj][1]; }
                            const f32x4 o0 = x0 * alpha + acc[ai][bj][m][0] * scale, o1 = x1 * alpha + acc[ai][bj][m][1] * scale;
                            u32x4 w; w.x = pk2(o0.x, o0.y); w.y = pk2(o0.z, o0.w); w.z = pk2(o1.x, o1.y); w.w = pk2(o1.z, o1.w);
                            *(u32x4*)(T + off + bj * 128) = w; } }
                }
                asm volatile("" ::: "memory");
            }
    }
};
struct EpiZ {
    static constexpr bool PERM = true, AFTER_DRAIN = false, HAS_MID = false;
    bf16* Zm; bf16* Zg;
    __device__ __forceinline__ void mid(f32x4 (&)[2][2][4][2], const pg8::Unit&, int, int, int, int) const {}
    __device__ __forceinline__ void operator()(const f32x4 (&acc)[2][2][4][2], const pg8::Unit& u, int wr, int wc, int fr, int fq) const {
        const int row0 = u.pm * 256 + wr * 64 + fr; int colt = u.pn * 256; bf16* base = Zm; int ld = ZM_LD;
        if (colt >= ZM_LD) { colt -= ZM_LD; base = Zg; ld = ZG_LD; }
        const int col0 = colt + wc * 32 + 8 * fq;
#pragma unroll
        for (int ai = 0; ai < 2; ++ai)
#pragma unroll
            for (int m = 0; m < 4; ++m) {
                bf16* rowp = base + (size_t)(row0 + ai * 128 + m * 16) * ld + col0;
#pragma unroll
                for (int bj = 0; bj < 2; ++bj) {
                    const f32x4 v0 = acc[ai][bj][m][0], v1 = acc[ai][bj][m][1];
                    u32x4 w; w.x = pk2(v0[0], v0[1]); w.y = pk2(v0[2], v0[3]); w.z = pk2(v1[0], v1[1]); w.w = pk2(v1[2], v1[3]);
                    *(u32x4*)(rowp + bj * 128) = w;
                }
            }
    }
};
struct EpiMerge {
    static constexpr bool PERM = true, AFTER_DRAIN = false, HAS_MID = true;
    const bf16* Zg; bf16* MG;
    __device__ __forceinline__ void mid(f32x4 (&acc)[2][2][4][2], const pg8::Unit& u, int wr, int wc, int fr, int fq) const {
        int row0 = u.pm * 256 + wr * 64 + fr; const int col0 = u.pn * 256 + wc * 32 + 8 * fq;
        asm volatile("" : "+v"(row0));
#pragma unroll
        for (int ai = 0; ai < 2; ++ai) {
            u32x4 ga[4][2], gb[4][2];
#pragma unroll
            for (int m = 0; m < 4; ++m) { const bf16* rowp = Zg + (size_t)(row0 + ai * 128 + m * 16) * ZG_LD + col0;
#pragma unroll
                for (int bj = 0; bj < 2; ++bj) { ga[m][bj] = *(const u32x4*)(rowp + bj * 128); gb[m][bj] = *(const u32x4*)(rowp + 2048 + bj * 128); } }
#pragma unroll
            for (int m = 0; m < 4; ++m)
#pragma unroll
                for (int bj = 0; bj < 2; ++bj) {
                    const unsigned gaw[4] = {ga[m][bj].x, ga[m][bj].y, ga[m][bj].z, ga[m][bj].w}, gbw[4] = {gb[m][bj].x, gb[m][bj].y, gb[m][bj].z, gb[m][bj].w};
#pragma unroll
                    for (int q = 0; q < 4; ++q) {
                        const float a0 = bflo(gaw[q]), a1 = bfhi(gaw[q]), b0 = bflo(gbw[q]), b1 = bfhi(gbw[q]);
                        const float f0 = (1.0f + fast_exp(-b0)) * __builtin_amdgcn_rcpf(1.0f + fast_exp(-a0));
                        const float f1 = (1.0f + fast_exp(-b1)) * __builtin_amdgcn_rcpf(1.0f + fast_exp(-a1));
                        acc[ai][bj][m][q >> 1][(q & 1) * 2 + 0] *= f0; acc[ai][bj][m][q >> 1][(q & 1) * 2 + 1] *= f1;
                    }
                }
            asm volatile("" ::: "memory");
        }
    }
    __device__ __forceinline__ void operator()(const f32x4 (&acc)[2][2][4][2], const pg8::Unit& u, int wr, int wc, int fr, int fq) const {
        asm volatile("" : "+v"(fr));
        const int row0 = u.pm * 256 + wr * 64 + fr, col0 = u.pn * 256 + wc * 32 + 8 * fq;
#pragma unroll
        for (int ai = 0; ai < 2; ++ai) {
            u32x4 gb[4][2];
#pragma unroll
            for (int m = 0; m < 4; ++m)
#pragma unroll
                for (int bj = 0; bj < 2; ++bj) gb[m][bj] = *(const u32x4*)(Zg + (size_t)(row0 + ai * 128 + m * 16) * ZG_LD + 2048 + col0 + bj * 128);
#pragma unroll
            for (int m = 0; m < 4; ++m) {
                const size_t r = (size_t)(row0 + ai * 128 + m * 16);
#pragma unroll
                for (int bj = 0; bj < 2; ++bj) {
                    const unsigned gbw[4] = {gb[m][bj].x, gb[m][bj].y, gb[m][bj].z, gb[m][bj].w};
                    float v[8];
#pragma unroll
                    for (int q = 0; q < 4; ++q) {
                        v[2 * q] = acc[ai][bj][m][q >> 1][(q & 1) * 2] * fast_sigmoid(bflo(gbw[q]));
                        v[2 * q + 1] = acc[ai][bj][m][q >> 1][(q & 1) * 2 + 1] * fast_sigmoid(bfhi(gbw[q]));
                    }
                    u32x4 w; w.x = pk2(v[0], v[1]); w.y = pk2(v[2], v[3]); w.z = pk2(v[4], v[5]); w.w = pk2(v[6], v[7]);
                    *(u32x4*)(MG + r * DM + col0 + bj * 128) = w;
                }
            }
            asm volatile("" ::: "memory");
        }
    }
};

__device__ __forceinline__ void tr_item(const float* __restrict__ W, int N, int k0, int n0, bf16* WT, size_t drow0, int ldk, int koff, LAS float* scr, int lane) {
#pragma unroll 8
    for (int i = 0; i < 32; ++i) { const int kk = 2 * i + (lane >> 5); scr[kk * 33 + (lane & 31)] = W[(size_t)(k0 + kk) * N + n0 + (lane & 31)]; }
    asm volatile("s_waitcnt lgkmcnt(0)" ::: "memory");
    const int c = lane & 7;
#pragma unroll
    for (int j = 0; j < 4; ++j) {
        const int n = (lane >> 3) + 8 * j; const LAS float* s = scr + (8 * c) * 33 + n;
        u32x4 o; o.x = pk2(s[0 * 33], s[1 * 33]); o.y = pk2(s[2 * 33], s[3 * 33]); o.z = pk2(s[4 * 33], s[5 * 33]); o.w = pk2(s[6 * 33], s[7 * 33]);
        *(u32x4*)(WT + (drow0 + n) * (size_t)ldk + koff + k0 + 8 * c) = o;
    }
    asm volatile("s_waitcnt lgkmcnt(0)" ::: "memory");
}
__device__ __forceinline__ void conv_mat(const float* W, int K, int N, bf16* WT, int ldk, int koff, int mode, int gw, int ngw, LAS float* scr, int lane) {
    asm volatile("" : "+v"(lane));
    const int nblk = N / 32, items = (K / 64) * nblk;
    float cur[32], nxt[32];
    int it = gw;
    if (it < items) { const int kb = it / nblk, nb = it - kb * nblk; const float* src = W + (size_t)(kb * 64 + (lane >> 5)) * N + nb * 32 + (lane & 31);
#pragma unroll
        for (int i = 0; i < 32; ++i) cur[i] = src[(size_t)(2 * i) * N]; }
    for (; it < items; it += ngw) {
        const int kb = it / nblk, nb = it - kb * nblk, n0 = nb * 32, k0 = kb * 64;
        const size_t drow0 = mode == 0 ? (size_t)n0 : (size_t)((n0 >> 7) * 256 + (n0 & 127) + (mode == 2 ? 128 : 0));
        const int itn = it + ngw;
        if (itn < items) { const int kbn = itn / nblk, nbn = itn - kbn * nblk; const float* src = W + (size_t)(kbn * 64 + (lane >> 5)) * N + nbn * 32 + (lane & 31);
#pragma unroll
            for (int i = 0; i < 32; ++i) nxt[i] = src[(size_t)(2 * i) * N]; }
#pragma unroll
        for (int i = 0; i < 32; ++i) scr[(2 * i + (lane >> 5)) * 33 + (lane & 31)] = cur[i];
        asm volatile("s_waitcnt lgkmcnt(0)" ::: "memory");
        const int c = lane & 7;
#pragma unroll
        for (int j = 0; j < 4; ++j) {
            const int n = (lane >> 3) + 8 * j; const LAS float* sp = scr + (8 * c) * 33 + n;
            u32x4 o; o.x = pk2(sp[0 * 33], sp[1 * 33]); o.y = pk2(sp[2 * 33], sp[3 * 33]); o.z = pk2(sp[4 * 33], sp[5 * 33]); o.w = pk2(sp[6 * 33], sp[7 * 33]);
            *(u32x4*)(WT + (drow0 + n) * (size_t)ldk + koff + k0 + 8 * c) = o;
        }
        asm volatile("s_waitcnt lgkmcnt(0)" ::: "memory");
#pragma unroll
        for (int i = 0; i < 32; ++i) cur[i] = nxt[i];
    }
}
__device__ __forceinline__ void ln_rows(bf16* T, const bf16* P, int tail_pm0, int nparts, const float* g, const float* b, float* Xf, bf16* Xb, float* st, int gw, int ngw, int lane) {
    asm volatile("" : "+v"(lane));
    f32x4 gg[8], bb[8], v[8]; u32x2 cur[8], nx[8];
#pragma unroll
    for (int j = 0; j < 8; ++j) { gg[j] = ((const f32x4*)g)[64 * j + lane]; bb[j] = ((const f32x4*)b)[64 * j + lane]; }
    int m = gw;
    if (m < MT) {
#pragma unroll
        for (int j = 0; j < 8; ++j) cur[j] = ((const u32x2*)(T + (size_t)m * DM))[64 * j + lane];
    }
    for (; m < MT; m += ngw) {
        const int mn = m + ngw;
        if (mn < MT) {
#pragma unroll
            for (int j = 0; j < 8; ++j) nx[j] = ((const u32x2*)(T + (size_t)mn * DM))[64 * j + lane];
        }
#pragma unroll
        for (int j = 0; j < 8; ++j) v[j] = (f32x4){bflo(cur[j].x), bfhi(cur[j].x), bflo(cur[j].y), bfhi(cur[j].y)};
        float s = 0.f;
        if (nparts > 0 && (m >> 8) >= tail_pm0) {
            for (int q = 0; q < nparts; ++q)
#pragma unroll
                for (int j = 0; j < 8; ++j) { const u32x2 p = *(const u32x2*)(P + (size_t)((((m >> 8) - tail_pm0) * 8 + j) * nparts + q) * 65536 + (size_t)(m & 255) * 256 + lane * 4);
                    v[j] += (f32x4){bflo(p.x), bfhi(p.x), bflo(p.y), bfhi(p.y)}; }
            if (st) {
#pragma unroll
                for (int j = 0; j < 8; ++j) { u32x2 w; w.x = pk2(v[j].x, v[j].y); w.y = pk2(v[j].z, v[j].w); ((u32x2*)(T + (size_t)m * DM))[64 * j + lane] = w;
                    v[j] = (f32x4){bflo(w.x), bfhi(w.x), bflo(w.y), bfhi(w.y)}; }
            }
        }
#pragma unroll
        for (int j = 0; j < 8; ++j) s += (v[j].x + v[j].y) + (v[j].z + v[j].w);
        const float mean = wave_sum(s) * (1.f / DM); float s2 = 0.f;
#pragma unroll
        for (int j = 0; j < 8; ++j) { v[j] = v[j] - mean; s2 += (v[j].x * v[j].x + v[j].y * v[j].y) + (v[j].z * v[j].z + v[j].w * v[j].w); }
        const float rstd = 1.0f / sqrtf(wave_sum(s2) * (1.f / DM) + 1e-5f);
        if (st && lane == 0) *(f32x2*)(st + (size_t)m * 2) = (f32x2){mean, rstd};
#pragma unroll
        for (int j = 0; j < 8; ++j) {
            const f32x4 o = v[j] * rstd * gg[j] + bb[j];
            if (Xf) ((f32x4*)(Xf + (size_t)m * DM))[64 * j + lane] = o;
            if (Xb) { u32x2 w; w.x = pk2(o.x, o.y); w.y = pk2(o.z, o.w); ((u32x2*)(Xb + (size_t)m * DM))[64 * j + lane] = w; }
        }
#pragma unroll
        for (int j = 0; j < 8; ++j) cur[j] = nx[j];
    }
}

constexpr int R_QS = 0, R_KS = 17408, R_KT = 34816, R_VT = 53248, R_SS = 71680, R_STB = 80896, R_GNX = 115712;
#define LDS_BARRIER() do { asm volatile("s_waitcnt lgkmcnt(0)" ::: "memory"); __builtin_amdgcn_s_barrier(); asm volatile("" ::: "memory"); } while (0)
template <bool STATE_ONLY>
__device__ __forceinline__ void ret_item(LAS unsigned char* lds, const bf16* __restrict__ Zm, int row0, int nchunks, int pos0, int h,
                                         const float* __restrict__ Sf, int nfold, float fdec, float* Sout, const float* __restrict__ tab,
                                         const float* __restrict__ gng, const float* __restrict__ gnb, bf16* Y) {
    const int tid = threadIdx.x, lane = tid & 63, w = __builtin_amdgcn_readfirstlane(tid >> 6), fr = lane & 15, fq = lane >> 4;
    const float log2g = log2f(1.0f - exp2f(-5.0f - (float)h));
    const float cdec = exp2f(64.0f * log2g);
    f32x4 S[8];
#pragma unroll
    for (int nt = 0; nt < 8; ++nt) S[nt] = (f32x4){0.f, 0.f, 0.f, 0.f};
    if (nfold > 0) {
        f32x4 fa[8];
#pragma unroll
        for (int k = 0; k < 8; ++k) fa[k] = (f32x4){0.f, 0.f, 0.f, 0.f};
        for (int j = 0; j < nfold; j += 4) {
            f32x4 ld[4][8];
#pragma unroll
            for (int u = 0; u < 4; ++u)
#pragma unroll
                for (int k = 0; k < 8; ++k) ld[u][k] = (j + u < nfold) ? *((const f32x4*)(Sf + (size_t)(j + u) * 16384) + tid + 512 * k) : (f32x4){0.f, 0.f, 0.f, 0.f};
#pragma unroll
            for (int u = 0; u < 4; ++u) if (j + u < nfold) {
#pragma unroll
                for (int k = 0; k < 8; ++k) fa[k] = fa[k] * fdec + ld[u][k];
            }
        }
#pragma unroll
        for (int k = 0; k < 8; ++k) { const int e = (tid + 512 * k) * 4, dk = e >> 7, dv = e & 127; *(LAS f32x4*)(lds + (dk * 132 + dv) * 4) = fa[k]; }
        LDS_BARRIER();
#pragma unroll
        for (int nt = 0; nt < 8; ++nt)
#pragma unroll
            for (int r = 0; r < 4; ++r) S[nt][r] = *(const LAS float*)(lds + ((nt * 16 + 4 * fq + r) * 132 + 16 * w + fr) * 4);
        LDS_BARRIER();
    }
    const int mt = w >> 1, wh = w & 1, j0 = w * 8;
    const float kdec = exp2f((float)(63 - lane) * log2g);
    const float qdec = exp2f((float)(mt * 16 + fr + 1) * log2g);
    f32x4 c0, c1, s0, s1; u32x4 q1, q2, k1, k2, v1, v2;
#define RET_LOAD_RAW(cc) do { const bf16* zr_ = Zm + (size_t)(row0 + (cc) * 64 + lane) * ZM_LD + h * 128 + j0; const float* tp_ = tab + (size_t)(pos0 + (cc) * 64 + lane) * 128 + j0; \
        c0 = *(const f32x4*)tp_; c1 = *(const f32x4*)(tp_ + 4); s0 = *(const f32x4*)(tp_ + 64); s1 = *(const f32x4*)(tp_ + 68); \
        q1 = *(const u32x4*)(zr_ + 2048); q2 = *(const u32x4*)(zr_ + 2048 + 64); k1 = *(const u32x4*)(zr_ + 3072); k2 = *(const u32x4*)(zr_ + 3072 + 64); \
        v1 = *(const u32x4*)(zr_ + 4096); v2 = *(const u32x4*)(zr_ + 4096 + 64); } while (0)
    RET_LOAD_RAW(0);
    for (int c = 0; c < nchunks; ++c) {
        const int rowc = row0 + c * 64;
        {
            const float cs[8] = {c0.x, c0.y, c0.z, c0.w, c1.x, c1.y, c1.z, c1.w}, sn[8] = {s0.x, s0.y, s0.z, s0.w, s1.x, s1.y, s1.z, s1.w};
            const unsigned q1w[4] = {q1.x, q1.y, q1.z, q1.w}, q2w[4] = {q2.x, q2.y, q2.z, q2.w}, k1w[4] = {k1.x, k1.y, k1.z, k1.w}, k2w[4] = {k2.x, k2.y, k2.z, k2.w};
            const unsigned v1w[4] = {v1.x, v1.y, v1.z, v1.w}, v2w[4] = {v2.x, v2.y, v2.z, v2.w};
            float qa[8], qb[8], ka[8], kb[8];
#pragma unroll
            for (int j = 0; j < 8; ++j) {
                const float x1 = (j & 1) ? bfhi(q1w[j >> 1]) : bflo(q1w[j >> 1]), x2 = (j & 1) ? bfhi(q2w[j >> 1]) : bflo(q2w[j >> 1]);
                qa[j] = x1 * cs[j] - x2 * sn[j]; qb[j] = x1 * sn[j] + x2 * cs[j];
                const float y1 = (j & 1) ? bfhi(k1w[j >> 1]) : bflo(k1w[j >> 1]), y2 = (j & 1) ? bfhi(k2w[j >> 1]) : bflo(k2w[j >> 1]);
                ka[j] = (y1 * cs[j] - y2 * sn[j]) * 0.08838834764831845f; kb[j] = (y1 * sn[j] + y2 * cs[j]) * 0.08838834764831845f;
            }
            if constexpr (!STATE_ONLY) {
            u32x4 t;
            t.x = pk2(qa[0], qa[1]); t.y = pk2(qa[2], qa[3]); t.z = pk2(qa[4], qa[5]); t.w = pk2(qa[6], qa[7]); *(LAS u32x4*)(lds + R_QS + lane * 272 + j0 * 2) = t;
            t.x = pk2(qb[0], qb[1]); t.y = pk2(qb[2], qb[3]); t.z = pk2(qb[4], qb[5]); t.w = pk2(qb[6], qb[7]); *(LAS u32x4*)(lds + R_QS + lane * 272 + (64 + j0) * 2) = t;
            t.x = pk2(ka[0], ka[1]); t.y = pk2(ka[2], ka[3]); t.z = pk2(ka[4], ka[5]); t.w = pk2(ka[6], ka[7]); *(LAS u32x4*)(lds + R_KS + lane * 272 + j0 * 2) = t;
            t.x = pk2(kb[0], kb[1]); t.y = pk2(kb[2], kb[3]); t.z = pk2(kb[4], kb[5]); t.w = pk2(kb[6], kb[7]); *(LAS u32x4*)(lds + R_KS + lane * 272 + (64 + j0) * 2) = t;
            }
#pragma unroll
            for (int j = 0; j < 8; ++j) {
                *(LAS unsigned short*)(lds + R_KT + (j0 + j) * 144 + lane * 2) = (unsigned short)f2bf(ka[j] * kdec);
                *(LAS unsigned short*)(lds + R_KT + (64 + j0 + j) * 144 + lane * 2) = (unsigned short)f2bf(kb[j] * kdec);
                *(LAS unsigned short*)(lds + R_VT + (j0 + j) * 144 + lane * 2) = (unsigned short)((j & 1) ? (v1w[j >> 1] >> 16) : (v1w[j >> 1] & 0xffffu));
                *(LAS unsigned short*)(lds + R_VT + (64 + j0 + j) * 144 + lane * 2) = (unsigned short)((j & 1) ? (v2w[j >> 1] >> 16) : (v2w[j >> 1] & 0xffffu));
            }
            if constexpr (!STATE_ONLY) {
#pragma unroll
            for (int nt = 0; nt < 8; ++nt) { u32x2 p; p.x = pk2(S[nt][0], S[nt][1]); p.y = pk2(S[nt][2], S[nt][3]); *(LAS u32x2*)(lds + R_STB + (16 * w + fr) * 272 + (nt * 16 + 4 * fq) * 2) = p; }
            }
        }
        if (c + 1 < nchunks) RET_LOAD_RAW(c + 1);
        if constexpr (STATE_ONLY) {
            LDS_BARRIER();
            const bf16x8 av0 = *(const LAS bf16x8*)(lds + R_VT + (16 * w + fr) * 144 + (fq * 8) * 2), av1 = *(const LAS bf16x8*)(lds + R_VT + (16 * w + fr) * 144 + (32 + fq * 8) * 2);
#pragma unroll
            for (int nt = 0; nt < 8; ++nt) {
                const bf16x8 b0 = *(const LAS bf16x8*)(lds + R_KT + (nt * 16 + fr) * 144 + (fq * 8) * 2), b1 = *(const LAS bf16x8*)(lds + R_KT + (nt * 16 + fr) * 144 + (32 + fq * 8) * 2);
                S[nt] = S[nt] * cdec; S[nt] = MFMA16(b0, av0, S[nt]); S[nt] = MFMA16(b1, av1, S[nt]);
            }
            LDS_BARRIER();
            continue;
        }
        u32x2 gz[4];
#pragma unroll
        for (int t4 = 0; t4 < 4; ++t4) gz[t4] = *(const u32x2*)(Zm + (size_t)(rowc + mt * 16 + fr) * ZM_LD + 5120 + h * 128 + (wh * 4 + t4) * 16 + 4 * fq);
        LDS_BARRIER();
        bf16x8 aq[4];
#pragma unroll
        for (int kk = 0; kk < 4; ++kk) aq[kk] = *(const LAS bf16x8*)(lds + R_QS + (mt * 16 + fr) * 272 + (kk * 32 + fq * 8) * 2);
        {
#pragma unroll
            for (int t2 = 0; t2 < 2; ++t2) {
                const int nt = wh * 2 + t2; f32x4 acc = {0.f, 0.f, 0.f, 0.f};
#pragma unroll
                for (int kk = 0; kk < 4; ++kk) { const bf16x8 b = *(const LAS bf16x8*)(lds + R_KS + (nt * 16 + fr) * 272 + (kk * 32 + fq * 8) * 2); acc = MFMA16(b, aq[kk], acc); }
                const int i = mt * 16 + fr; float sv[4];
#pragma unroll
                for (int r = 0; r < 4; ++r) { const int d = i - (nt * 16 + 4 * fq + r); sv[r] = d >= 0 ? acc[r] * exp2f((float)d * log2g) : 0.f; }
                u32x2 p; p.x = pk2(sv[0], sv[1]); p.y = pk2(sv[2], sv[3]);
                *(LAS u32x2*)(lds + R_SS + i * 144 + (nt * 16 + 4 * fq) * 2) = p;
            }
        }
        LDS_BARRIER();
        f32x4 o[4];
        {
            bf16x8 as0 = *(const LAS bf16x8*)(lds + R_SS + (mt * 16 + fr) * 144 + (fq * 8) * 2), as1 = *(const LAS bf16x8*)(lds + R_SS + (mt * 16 + fr) * 144 + (32 + fq * 8) * 2);
#pragma unroll
            for (int t4 = 0; t4 < 4; ++t4) {
                const int nb = wh * 4 + t4; f32x4 ai = {0.f, 0.f, 0.f, 0.f}, ax = {0.f, 0.f, 0.f, 0.f};
                const bf16x8 bv0 = *(const LAS bf16x8*)(lds + R_VT + (nb * 16 + fr) * 144 + (fq * 8) * 2), bv1 = *(const LAS bf16x8*)(lds + R_VT + (nb * 16 + fr) * 144 + (32 + fq * 8) * 2);
                ai = MFMA16(bv0, as0, ai); ai = MFMA16(bv1, as1, ai);
#pragma unroll
                for (int kk = 0; kk < 4; ++kk) { const bf16x8 b = *(const LAS bf16x8*)(lds + R_STB + (nb * 16 + fr) * 272 + (kk * 32 + fq * 8) * 2); ax = MFMA16(b, aq[kk], ax); }
                o[t4] = ai + ax * qdec;
            }
        }
        {
            const bf16x8 av0 = *(const LAS bf16x8*)(lds + R_VT + (16 * w + fr) * 144 + (fq * 8) * 2), av1 = *(const LAS bf16x8*)(lds + R_VT + (16 * w + fr) * 144 + (32 + fq * 8) * 2);
#pragma unroll
            for (int nt = 0; nt < 8; ++nt) {
                const bf16x8 b0 = *(const LAS bf16x8*)(lds + R_KT + (nt * 16 + fr) * 144 + (fq * 8) * 2), b1 = *(const LAS bf16x8*)(lds + R_KT + (nt * 16 + fr) * 144 + (32 + fq * 8) * 2);
                S[nt] = S[nt] * cdec; S[nt] = MFMA16(b0, av0, S[nt]); S[nt] = MFMA16(b1, av1, S[nt]);
            }
        }
        {
            float s1 = 0.f, s2 = 0.f;
#pragma unroll
            for (int t4 = 0; t4 < 4; ++t4)
#pragma unroll
                for (int r = 0; r < 4; ++r) { s1 += o[t4][r]; s2 += o[t4][r] * o[t4][r]; }
            s1 += __shfl_xor(s1, 16); s1 += __shfl_xor(s1, 32); s2 += __shfl_xor(s2, 16); s2 += __shfl_xor(s2, 32);
            const int i = mt * 16 + fr;
            if (fq == 0) *(LAS f32x2*)(lds + R_GNX + (i * 2 + wh) * 8) = (f32x2){s1, s2};
            f32x4 gnG[4], gnB[4];
#pragma unroll
            for (int t4 = 0; t4 < 4; ++t4) { const int gcol = h * 128 + (wh * 4 + t4) * 16 + 4 * fq; gnG[t4] = *(const f32x4*)(gng + gcol); gnB[t4] = *(const f32x4*)(gnb + gcol); }
            LDS_BARRIER();
            const f32x2 p0 = *(const LAS f32x2*)(lds + R_GNX + (i * 2) * 8), p1 = *(const LAS f32x2*)(lds + R_GNX + (i * 2 + 1) * 8);
            const float mean = (p0.x + p1.x) * (1.f / 128.f), var = (p0.y + p1.y) * (1.f / 128.f) - mean * mean;
            const float rstd = 1.0f / sqrtf(fmaxf(var, 0.f) + 1e-5f);
            const size_t grow = (size_t)(rowc + i);
#pragma unroll
            for (int t4 = 0; t4 < 4; ++t4) {
                const int gcol = h * 128 + (wh * 4 + t4) * 16 + 4 * fq;
                const f32x4 gg = gnG[t4], gb = gnB[t4];
                const float g0 = bflo(gz[t4].x), g1 = bfhi(gz[t4].x), g2 = bflo(gz[t4].y), g3 = bfhi(gz[t4].y);
                const float y0 = ((o[t4][0] - mean) * rstd * gg.x + gb.x) * g0 * fast_sigmoid(g0);
                const float y1 = ((o[t4][1] - mean) * rstd * gg.y + gb.y) * g1 * fast_sigmoid(g1);
                const float y2 = ((o[t4][2] - mean) * rstd * gg.z + gb.z) * g2 * fast_sigmoid(g2);
                const float y3 = ((o[t4][3] - mean) * rstd * gg.w + gb.w) * g3 * fast_sigmoid(g3);
                u32x2 p; p.x = pk2(y0, y1); p.y = pk2(y2, y3);
                *(u32x2*)(Y + grow * DM + 1024 + gcol) = p;
            }
        }
    }
    if (Sout) {
#pragma unroll
        for (int nt = 0; nt < 8; ++nt)
#pragma unroll
            for (int r = 0; r < 4; ++r) Sout[(size_t)(nt * 16 + 4 * fq + r) * 128 + 16 * w + fr] = S[nt][r];
    }
#undef RET_LOAD_RAW
}

constexpr int L_GW = 0, L_WV = 18432, L_WVB = 10752, L_CAR = L_WV + 8 * L_WVB, L_RC = L_CAR + 4096;
__device__ __forceinline__ void lru_stage_gw(LAS unsigned char* lds, const bf16* rgT, const bf16* igT, int n) {
    const int tid = threadIdx.x;
#pragma unroll
    for (int i = 0; i < 2; ++i) {
        const int e = tid + i * 512, g = e >> 9, rem = e & 511, row = rem >> 3, c8 = rem & 7;
        const u32x4 v = *(const u32x4*)((g ? igT : rgT) + (size_t)n * 4096 + row * 64 + c8 * 8);
        *(LAS u32x4*)(lds + L_GW + g * 9216 + row * 144 + c8 * 16) = v;
    }
}
struct LruConst { float cw0, cw1, cw2, cw3, cb, rb, ib, cneg; };
__device__ __forceinline__ float em1(float x) {
    return x * (1.0f + x * (0.5f + x * (0.16666667f + x * (0.041666668f + x * (0.008333334f + x * (0.0013888889f + x * (0.0001984127f + x * 0.0000248016f)))))));
}
__device__ __forceinline__ f32x2 lru_local_task(LAS unsigned char* lds, const bf16* __restrict__ Zm, int row0, int n, const LruConst& K,
                                                float xm3, float xm2, float xm1, unsigned* HLA) {
    const int tid = threadIdx.x, lane = tid & 63, w = __builtin_amdgcn_readfirstlane(tid >> 6), fr = lane & 15, fq = lane >> 4;
    const int c = n * 64 + lane;
    LAS unsigned char* XC = lds + L_WV + w * L_WVB; LAS unsigned char* DG = XC + 2304;
    float A = 1.f, hl = 0.f;
#pragma unroll
    for (int mt = 0; mt < 2; ++mt) {
        float xc[16];
        const bf16* xp = Zm + (size_t)(row0 + mt * 16) * ZM_LD + c;
#pragma unroll
        for (int t = 0; t < 16; ++t) {
            const float x = bf2f(xp[t * ZM_LD]);
            xc[t] = K.cb + K.cw0 * xm3 + K.cw1 * xm2 + K.cw2 * xm1 + K.cw3 * x;
            xm3 = xm2; xm2 = xm1; xm1 = x;
            *(LAS unsigned short*)(XC + t * 144 + lane * 2) = (unsigned short)f2bf(xc[t]);
        }
        asm volatile("s_waitcnt lgkmcnt(0)" ::: "memory");
        const bf16x8 a0 = *(const LAS bf16x8*)(XC + fr * 144 + fq * 16), a1 = *(const LAS bf16x8*)(XC + fr * 144 + 64 + fq * 16);
#pragma unroll
        for (int g = 0; g < 2; ++g)
#pragma unroll
            for (int nt = 0; nt < 4; ++nt) {
                const bf16x8 b0 = *(const LAS bf16x8*)(lds + L_GW + g * 9216 + (nt * 16 + fr) * 144 + fq * 16), b1 = *(const LAS bf16x8*)(lds + L_GW + g * 9216 + (nt * 16 + fr) * 144 + 64 + fq * 16);
                f32x4 acc = {0.f, 0.f, 0.f, 0.f};
                acc = MFMA16(b0, a0, acc); acc = MFMA16(b1, a1, acc);
                *(LAS f32x4*)(DG + fr * 528 + (g * 64 + nt * 16 + 4 * fq) * 4) = acc;
            }
        asm volatile("s_waitcnt lgkmcnt(0)" ::: "memory");
        unsigned* hp = HLA + (size_t)(row0 + mt * 16) * DRNN + c;
#pragma unroll
        for (int t = 0; t < 16; ++t) {
            const float gr = *(const LAS float*)(DG + t * 528 + lane * 4), gi = *(const LAS float*)(DG + t * 528 + 256 + lane * 4);
            const float r = fast_sigmoid(gr + K.rb), ig = fast_sigmoid(gi + K.ib);
            const float la = r * K.cneg;
            const float a = 1.0f + em1(la);
            const float u = sqrtf(-em1(2.0f * la)) * ig * xc[t];
            A *= a; hl = a * hl + u;
            hp[t * DRNN] = pk2(hl, A);
        }
        asm volatile("s_waitcnt lgkmcnt(0)" ::: "memory");
    }
    return (f32x2){A, hl};
}
__device__ __forceinline__ void lru_final_task(const bf16* __restrict__ Zm, bf16* Y, const unsigned* __restrict__ HLA, const float* __restrict__ SS,
                                               const float* __restrict__ RS, int g, int n, int lane, const float* __restrict__ state_lru, float* out) {
    const int c = n * 64 + lane, row0 = g * 32;
    float hin = 0.f; float* h_out = nullptr; float* conv_out = nullptr; int r0 = 0, r1 = 0, s0;
    if (g < 256) { r0 = (g >> 6) << 3; r1 = g >> 3; s0 = g & ~7; if ((g & 63) == 63) { h_out = out + O_LRUP + (size_t)(g >> 6) * DRNN; conv_out = out + O_CONVP + (size_t)(g >> 6) * 3 * DRNN; } }
    else { const int sidx = (g - 256) >> 1; s0 = g & ~1; hin = state_lru[(size_t)sidx * DRNN + c]; if (g & 1) { h_out = out + O_LRUS + (size_t)sidx * DRNN; conv_out = out + O_CONVS + (size_t)sidx * 3 * DRNN; } }
    {
        f32x2 p[8];
#pragma unroll
        for (int u = 0; u < 8; ++u) p[u] = (r0 + u < r1) ? *(const f32x2*)(RS + ((size_t)(r0 + u) * DRNN + c) * 2) : (f32x2){1.f, 0.f};
#pragma unroll
        for (int u = 0; u < 8; ++u) hin = p[u].x * hin + p[u].y;
#pragma unroll
        for (int u = 0; u < 8; ++u) p[u] = (s0 + u < g) ? *(const f32x2*)(SS + ((size_t)(s0 + u) * DRNN + c) * 2) : (f32x2){1.f, 0.f};
#pragma unroll
        for (int u = 0; u < 8; ++u) hin = p[u].x * hin + p[u].y;
    }
    float hv = 0.f;
#pragma unroll
    for (int tg = 0; tg < 4; ++tg) {
        const size_t r = (size_t)(row0 + tg * 8);
        float hl[8], ac[8], gav[8];
#pragma unroll
        for (int t = 0; t < 8; ++t) { const unsigned w = HLA[(r + t) * DRNN + c]; hl[t] = bflo(w); ac[t] = bfhi(w); gav[t] = bf2f(Zm[(r + t) * ZM_LD + 1024 + c]); }
#pragma unroll
        for (int t = 0; t < 8; ++t) {
            hv = hl[t] + ac[t] * hin; const float ga = gav[t];
            const float y = hv * ga * fast_sigmoid(1.5957691216057308f * (ga + 0.044715f * ga * ga * ga));
            Y[(r + t) * DM + c] = (bf16)f2bf(y);
        }
        asm volatile("" ::: "memory");
    }
    if (h_out) { h_out[c] = hv; conv_out[c] = bf2f(Zm[(size_t)(row0 + 29) * ZM_LD + c]); conv_out[1024 + c] = bf2f(Zm[(size_t)(row0 + 30) * ZM_LD + c]); conv_out[2048 + c] = bf2f(Zm[(size_t)(row0 + 31) * ZM_LD + c]); }
}
__device__ __forceinline__ LruConst lru_consts(const float* cw, const float* cb, const float* rgb, const float* igb, const float* lam, int c) {
    LruConst K; K.cw0 = cw[c]; K.cw1 = cw[1024 + c]; K.cw2 = cw[2048 + c]; K.cw3 = cw[3072 + c]; K.cb = cb[c]; K.rb = rgb[c]; K.ib = igb[c];
    const float l = lam[c];
    K.cneg = -8.0f * log1pf(expf(-l));
    return K;
}

#define XB_TMO      128
#define XB_XCNT(j)  (256  + 64 * (j))
#define XB_XSUB(j)  (1280 + 64 * (j))
#define XB_XGEN(j)  (2304 + 64 * (j))
#define XB_TOP      3328
#define XB_TOPGEN   3392
#define XCD_BAR_WORDS 3456
#define XB_SPIN_CAP (1u << 18)

__device__ __forceinline__ unsigned xb_ld(unsigned* p)              { return __hip_atomic_load(p, __ATOMIC_RELAXED, __HIP_MEMORY_SCOPE_AGENT); }
__device__ __forceinline__ unsigned xb_add(unsigned* p, unsigned v) { return __hip_atomic_fetch_add(p, v, __ATOMIC_RELAXED, __HIP_MEMORY_SCOPE_AGENT); }
__device__ __forceinline__ unsigned xb_xcc_id() { return (unsigned)__builtin_amdgcn_s_getreg((3 << 11) | 20) & 0xFu; }
#define XB_SPIN(cond, bar) do { unsigned _sp = 0; while (cond) { __builtin_amdgcn_s_sleep(1); \
    if ((++_sp & 255u) == 0u) { if (xb_ld(&(bar)[XB_TMO])) break; if (_sp > XB_SPIN_CAP) { atomicAdd(&(bar)[XB_TMO], 1u); break; } } } } while (0)

struct XcdBarrier {
    unsigned* bar; unsigned x;
    volatile LAS unsigned* st;
};

__device__ __forceinline__ XcdBarrier xcd_barrier_post(unsigned* bar, volatile LAS unsigned* st) {
    XcdBarrier b; b.bar = bar; b.x = xb_xcc_id(); b.st = st;
    if (threadIdx.x == 0) (void)xb_add(&bar[XB_XCNT(b.x)], 1u);
    return b;
}
__device__ __forceinline__ void xcd_barrier_complete(unsigned* bar, unsigned x, unsigned& nloc, unsigned& nx) {
    const unsigned G = gridDim.x * gridDim.y * gridDim.z;
    unsigned sum, cnt, mine, sp = 0u;
    for (;;) {
        sum = 0u; cnt = 0u; mine = 0u;
#pragma unroll
        for (unsigned j = 0; j < 16; ++j) { const unsigned c = xb_ld(&bar[XB_XCNT(j)]); sum += c; cnt += (c > 0u) ? 1u : 0u; mine = (j == x) ? c : mine; }
        if (sum == G) break;
        __builtin_amdgcn_s_sleep(1);
        if ((++sp & 255u) == 0u) { if (xb_ld(&bar[XB_TMO])) break; if (sp > XB_SPIN_CAP) { atomicAdd(&bar[XB_TMO], 1u); break; } }
    }
    nloc = mine > 0u ? mine : 1u; nx = cnt > 0u ? cnt : 1u;
}

__device__ __forceinline__ void xcd_barrier(const XcdBarrier& b) {
    asm volatile("s_waitcnt vmcnt(0)" ::: "memory");
    __syncthreads();
    if (threadIdx.x == 0) {
        unsigned* bar = b.bar;
        __builtin_amdgcn_s_waitcnt(0);
        unsigned nloc = b.st[0], nx = b.st[1];
        if (nloc == 0u) { xcd_barrier_complete(bar, b.x, nloc, nx); b.st[0] = nloc; b.st[1] = nx; }
        const unsigned old = xb_add(&bar[XB_XSUB(b.x)], 1u);
        const unsigned gen = old / nloc;
        if (old + 1u == (gen + 1u) * nloc) {
            __builtin_amdgcn_fence(__ATOMIC_RELEASE, "agent");
            asm volatile("s_waitcnt vmcnt(0)" ::: "memory");
            const unsigned og = xb_add(&bar[XB_TOP], 1u);
            const unsigned tg = og / nx;
            if (og + 1u == (tg + 1u) * nx) xb_add(&bar[XB_TOPGEN], 1u);
            else XB_SPIN(xb_ld(&bar[XB_TOPGEN]) == tg, bar);
            __builtin_amdgcn_fence(__ATOMIC_ACQUIRE, "agent");
            xb_add(&bar[XB_XGEN(b.x)], 1u);
            asm volatile("s_waitcnt vmcnt(0)" ::: "memory");
        } else {
            XB_SPIN(xb_ld(&bar[XB_XGEN(b.x)]) == gen, bar);
            __builtin_amdgcn_fence(__ATOMIC_ACQUIRE, "agent");
            asm volatile("s_waitcnt vmcnt(0)" ::: "memory");
        }
    }
    __syncthreads();
}

struct Args { const float* in[30]; float* out; unsigned char* ws; };
static_assert(sizeof(Args) == 32 * 8, "Args has no padding");

__global__ void __launch_bounds__(NTHREADS, 2) fwd_megakernel(Args a) {
    extern __shared__ __attribute__((aligned(16))) unsigned char lds_raw[];
    LAS unsigned char* lds = (LAS unsigned char*)lds_raw;
    cg::grid_group grid = cg::this_grid();
    if (threadIdx.x < 8) ((volatile LAS unsigned*)(lds + 131072))[threadIdx.x] = 0u;
    __syncthreads();
    if (blockIdx.x == 0) for (int i = threadIdx.x; i < 4096; i += NTHREADS) ((unsigned*)a.ws)[i] = 0u;
    const int tid = threadIdx.x, lane = tid & 63, wave = __builtin_amdgcn_readfirstlane(tid >> 6);
    const int G = gridDim.x, blk = blockIdx.x;
    const int gw = blk * NWAVES + wave, ngw = G * NWAVES;
    const int vcu = (G % 8 == 0) ? (blk % 8) * (G / 8) + blk / 8 : blk;
    unsigned char* ws = a.ws;
    float* tab = (float*)(ws + WS_TAB);
    float* ST1 = (float*)(ws + WS_TAB + 1081344); float* ST2 = ST1 + (size_t)MT * 2;
    bf16* rgT = (bf16*)(ws + WS_GATEW); bf16* igT = rgT + 16 * 4096;
    bf16* Wgu = (bf16*)(ws + WS_WGU); bf16* Wd = (bf16*)(ws + WS_WD); bf16* Win = (bf16*)(ws + WS_WIN); bf16* Wab = (bf16*)(ws + WS_WAB); bf16* Wo = (bf16*)(ws + WS_WO);
    bf16* XNB = (bf16*)(ws + WS_XNB); float* X1 = (float*)(ws + WS_X1); bf16* Hb = (bf16*)(ws + WS_H); bf16* Zm = (bf16*)(ws + WS_H); bf16* MG = (bf16*)(ws + WS_H);
    float* T = (float*)(ws + WS_T); bf16* Zg = (bf16*)(ws + WS_T);
    LAS float* scr = (LAS float*)(lds + wave * 8448);

    conv_mat(a.in[5], DM, DFF, Wgu, DM, 0, 1, gw, ngw, scr, lane);
    conv_mat(a.in[6], DM, DFF, Wgu, DM, 0, 2, gw, ngw, scr, lane);
    conv_mat(a.in[10], DM, 10240, Win, DM, 0, 0, gw, ngw, scr, lane);
    for (int it = gw; it < 64; it += ngw) {
        const int g = it >> 5, n = (it >> 1) & 15, nh = it & 1;
        tr_item(a.in[g ? 15 : 13] + (size_t)n * 4096, 64, 0, nh * 32, (g ? igT : rgT) + (size_t)n * 4096, (size_t)nh * 32, 64, 0, scr, lane);
    }
    {
        const size_t n8 = (size_t)MT * DM / 8, np8 = (size_t)MP * DM / 8;
        const size_t gstr = (size_t)G * NTHREADS;
        for (size_t i0 = (size_t)blk * NTHREADS + tid; i0 < n8; i0 += 4 * gstr) {
            f32x4 v0[4], v1[4];
#pragma unroll
            for (int u = 0; u < 4; ++u) { const size_t i = i0 + u * gstr; if (i < n8) { const float* src = i < np8 ? a.in[0] + i * 8 : a.in[1] + (i - np8) * 8; v0[u] = *(const f32x4*)src; v1[u] = *(const f32x4*)(src + 4); } }
#pragma unroll
            for (int u = 0; u < 4; ++u) { const size_t i = i0 + u * gstr; if (i < n8) { u32x4 w; w.x = pk2(v0[u].x, v0[u].y); w.y = pk2(v0[u].z, v0[u].w); w.z = pk2(v1[u].x, v1[u].y); w.w = pk2(v1[u].z, v1[u].w); *(u32x4*)(XNB + i * 8) = w; } }
        }
        for (int i = blk * NTHREADS + tid; i < NPOS * 64; i += G * NTHREADS) {
            const int p = i >> 6, j = i & 63;
            const float invf = exp2f(-(float)(2 * j) * (13.287712379549449f / 128.0f));
            double rev = (double)p * (double)invf * 0.15915494309189535; rev -= floor(rev);
            const float rf = (float)rev;
            tab[(size_t)p * 128 + j] = __builtin_amdgcn_cosf(rf); tab[(size_t)p * 128 + 64 + j] = __builtin_amdgcn_sinf(rf);
        }
    }
    grid.sync();
    const XcdBarrier xbar = xcd_barrier_post((unsigned*)a.ws, (volatile LAS unsigned*)(lds + 131072));

    { pg8::Gemm g{XNB, Wgu, MT, 2 * DFF, DM}; pg8::StaticOrder S; S.init(MT, 2 * DFF, G, blk, DM); EpiSwiglu E{Hb};
      pg8::gemm_phase<EpiSwiglu, pg8::StaticOrder, true, true>(lds, g, S, E); }
    {
        const int nbusy = (40 * 44) % G; int cgw = gw, cngw = ngw;
        if (nbusy != 0) { cgw = blk >= nbusy ? (blk - nbusy) * NWAVES + wave : -1; cngw = (G - nbusy) * NWAVES; }
        if (cgw >= 0) conv_mat(a.in[7], DFF, DM, Wd, DFF, 0, 0, cgw, cngw, scr, lane);
    }
    xcd_barrier(xbar);
    { pg8::TailSplitOrder SKd; { int G2 = G; asm volatile("" : "+s"(G2)); SKd.init(MT, DM, DFF, G2, vcu); } pg8::Gemm g{Hb, Wd, MT, DM, DFF}; EpiRes<false, true> E; E.RB = XNB; E.T = (bf16*)X1;     E.P = (bf16*)a.out; E.st = ST1; E.lg = a.in[8]; E.lb = a.in[9];
      pg8::gemm_phase<EpiRes<false, true>, pg8::TailSplitOrder, true, true>(lds, g, SKd, E); }
    xcd_barrier(xbar);
    { pg8::TailSplitOrder SKd; { int G2 = G; asm volatile("" : "+s"(G2)); SKd.init(MT, DM, DFF, G2, vcu); } ln_rows((bf16*)X1, (const bf16*)a.out, SKd.tail_pm0(), SKd.split - 1, a.in[8], a.in[9], nullptr, XNB, ST1, gw, ngw, lane); }
    xcd_barrier(xbar);
    { pg8::Gemm g{XNB, Win, MT, 10240, DM}; pg8::StaticOrder S; S.init(MT, 10240, G, blk, DM); EpiZ E{Zm, Zg};
      pg8::gemm_phase<EpiZ, pg8::StaticOrder, true, true>(lds, g, S, E); }
    {
        const int nbusy = (40 * 40) % G; int cgw = gw, cngw = ngw;
        if (nbusy != 0) { cgw = blk >= nbusy ? (blk - nbusy) * NWAVES + wave : -1; cngw = (G - nbusy) * NWAVES; }
        if (cgw >= 0) {
            conv_mat(a.in[20], DRNN, DM, Wab, DM, 0, 0, cgw, cngw, scr, lane);
            conv_mat(a.in[21], DRNN, DM, Wab, DM, 1024, 0, cgw, cngw, scr, lane);
            conv_mat(a.in[22], DM, DM, Wo, DM, 0, 0, cgw, cngw, scr, lane);
        }
    }
    xcd_barrier(xbar);
    {
        bf16* Y = XNB;
        const float* gng = a.in[18]; const float* gnb = a.in[19];
        unsigned* HLA = (unsigned*)(ws + WS_WGU);
        float* SLOC = (float*)(HLA + (size_t)MT * DRNN);
        float* SSUM = SLOC + (size_t)NB * NHEAD * 8 * 16384;
        float* RSUM = SSUM + (size_t)320 * DRNN * 2;
        int staged_n = -1; LruConst K = {};
        for (int i = blk; i < 640 + 224; i += G) {
            if (i < 640) {
                const int n = i & 15, sg = i >> 4, g = sg * 8 + wave, row0 = g * 32, c = n * 64 + lane;
                __syncthreads();
                if (n != staged_n) {
                    lru_stage_gw(lds, rgT, igT, n);
                    K = lru_consts(a.in[11], a.in[12], a.in[14], a.in[16], a.in[17], c);
                    staged_n = n;
                    __syncthreads();
                }
                float xm3 = 0.f, xm2 = 0.f, xm1 = 0.f;
                const bool first = g < 256 ? ((g & 63) == 0) : ((g & 1) == 0);
                if (!first) { xm3 = bf2f(Zm[(size_t)(row0 - 3) * ZM_LD + c]); xm2 = bf2f(Zm[(size_t)(row0 - 2) * ZM_LD + c]); xm1 = bf2f(Zm[(size_t)(row0 - 1) * ZM_LD + c]); }
                else if (g >= 256) { const float* sc = a.in[2] + (size_t)((g - 256) >> 1) * 3 * DRNN; xm3 = sc[c]; xm2 = sc[1024 + c]; xm1 = sc[2048 + c]; }
                const f32x2 sm = lru_local_task(lds, Zm, row0, n, K, xm3, xm2, xm1, HLA);
                *(f32x2*)(SSUM + ((size_t)g * DRNN + c) * 2) = sm;
                *(LAS f32x2*)(lds + L_CAR + (wave * 64 + lane) * 8) = sm;
                __syncthreads();
                if (wave == 0) {
                    float Ar = 1.f, hr = 0.f;
#pragma unroll
                    for (int w2 = 0; w2 < 8; ++w2) { const f32x2 p = *(const LAS f32x2*)(lds + L_CAR + (w2 * 64 + lane) * 8); hr = p.x * hr + p.y; Ar *= p.x; }
                    *(f32x2*)(RSUM + ((size_t)sg * DRNN + c) * 2) = (f32x2){Ar, hr};
                }
            } else {
                const int j = i - 640, bh = j / 7, sgm = j - bh * 7;
                __syncthreads();
                staged_n = -1;
                ret_item<true>(lds, Zm, (bh >> 3) * SEQ + sgm * 256, 4, sgm * 256, bh & 7, nullptr, 0, 0.f, SLOC + (size_t)(bh * 8 + sgm) * 16384, tab, gng, gnb, Y);
            }
        }
        xcd_barrier(xbar);
        for (int i = blk; i < 512; i += G) {
            __syncthreads();
            if (i < 256) {
                const int bh = i >> 3, sgm = i & 7, h = bh & 7;
                const float fdec = exp2f(256.0f * log2f(1.0f - exp2f(-5.0f - (float)h)));
                ret_item<false>(lds, Zm, (bh >> 3) * SEQ + sgm * 256, 4, sgm * 256, h, SLOC + (size_t)(bh * 8) * 16384, sgm, fdec,
                                sgm == 7 ? a.out + O_RETP + (size_t)bh * 16384 : nullptr, tab, gng, gnb, Y);
            } else {
                const int j = i - 256, sidx = j >> 3, h = j & 7;
                ret_item<false>(lds, Zm, MP + sidx * DSEQ, 1, SEQ, h, a.in[4] + (size_t)j * 16384, 1, 0.f, a.out + O_RETS + (size_t)j * 16384, tab, gng, gnb, Y);
            }
        }
        for (int wt = gw; wt < 320 * 16; wt += ngw) lru_final_task(Zm, Y, HLA, SSUM, RSUM, wt >> 4, wt & 15, lane, a.in[3], a.out);
    }
    xcd_barrier(xbar);
    { pg8::Gemm g{XNB, Wab, MT, DM, DM}; pg8::StaticOrder S; S.init(MT, DM, G, blk, DM); EpiMerge E{Zg, MG};
      pg8::gemm_phase<EpiMerge, pg8::StaticOrder, true, true>(lds, g, S, E); }
    {
        const int nbusy = (40 * 8) % G; int cgw = gw, cngw = ngw;
        if (nbusy != 0) { cgw = blk >= nbusy ? (blk - nbusy) * NWAVES + wave : -1; cngw = (G - nbusy) * NWAVES; }
        if (cgw >= 0) {
            conv_mat(a.in[25], DM, DFF, Wgu, DM, 0, 1, cgw, cngw, scr, lane);
            conv_mat(a.in[26], DM, DFF, Wgu, DM, 0, 2, cgw, cngw, scr, lane);
            conv_mat(a.in[27], DFF, DM, Wd, DFF, 0, 0, cgw, cngw, scr, lane);
        }
    }
    xcd_barrier(xbar);
    { pg8::TailSplitOrder SKo; { int G2 = G; asm volatile("" : "+s"(G2)); SKo.init(MT, DM, DM, G2, vcu); } pg8::Gemm g{MG, Wo, MT, DM, DM}; EpiRes<true, false> E; E.RB = (const bf16*)X1; E.T = (bf16*)X1; E.P = (bf16*)a.out; E.st = ST1; E.lg = a.in[8]; E.lb = a.in[9];
      pg8::gemm_phase<EpiRes<true, false>, pg8::TailSplitOrder, true, true>(lds, g, SKo, E); }
    xcd_barrier(xbar);
    { pg8::TailSplitOrder SKo; { int G2 = G; asm volatile("" : "+s"(G2)); SKo.init(MT, DM, DM, G2, vcu); } ln_rows((bf16*)X1, (const bf16*)a.out, SKo.tail_pm0(), SKo.split - 1, a.in[23], a.in[24], nullptr, XNB, ST2, gw, ngw, lane); }
    xcd_barrier(xbar);
    { pg8::Gemm g{XNB, Wgu, MT, 2 * DFF, DM}; pg8::StaticOrder S; S.init(MT, 2 * DFF, G, blk, DM); EpiSwiglu E{Hb};
      pg8::gemm_phase<EpiSwiglu, pg8::StaticOrder, true, true>(lds, g, S, E); }
    xcd_barrier(xbar);
    { pg8::TailSplitOrder SKd; { int G2 = G; asm volatile("" : "+s"(G2)); SKd.init(MT, DM, DFF, G2, vcu); } pg8::Gemm g{Hb, Wd, MT, DM, DFF}; EpiRes<true, true> E; E.RB = (const bf16*)X1; E.T = (bf16*)T; E.P = (bf16*)(ws + WS_WIN); E.st = ST2; E.lg = a.in[23]; E.lb = a.in[24];
      pg8::gemm_phase<EpiRes<true, true>, pg8::TailSplitOrder, true, true>(lds, g, SKd, E); }
    xcd_barrier(xbar);
    { pg8::TailSplitOrder SKd; { int G2 = G; asm volatile("" : "+s"(G2)); SKd.init(MT, DM, DFF, G2, vcu); } ln_rows((bf16*)T, (const bf16*)(ws + WS_WIN), SKd.tail_pm0(), SKd.split - 1, a.in[28], a.in[29], a.out + O_Y, nullptr, nullptr, gw, ngw, lane); }
}

extern "C" void kernel_launch(void* const* d_in, const int* in_sizes, int n_in, void* d_out, int out_size, void* d_ws, size_t ws_size, hipStream_t stream) {
    static int grid = 0;
    if (grid == 0) {
        if (n_in != 30 || ws_size < WS_END) { fprintf(stderr, "kernel_launch: unexpected n_in %d or ws_size %zu (need %zu)\n", n_in, ws_size, (size_t)WS_END); grid = -1; return; }
        int dev = 0, cus = 0, per_cu = 0;
        hipGetDevice(&dev);
        hipDeviceGetAttribute(&cus, hipDeviceAttributeMultiprocessorCount, dev);
        if (hipFuncSetAttribute((const void*)fwd_megakernel, hipFuncAttributeMaxDynamicSharedMemorySize, LDS_BYTES) != hipSuccess) { fprintf(stderr, "kernel_launch: hipFuncSetAttribute failed\n"); grid = -1; return; }
        if (hipOccupancyMaxActiveBlocksPerMultiprocessor(&per_cu, (const void*)fwd_megakernel, NTHREADS, LDS_BYTES) != hipSuccess || per_cu < 1) { fprintf(stderr, "kernel_launch: occupancy query says %d\n", per_cu); per_cu = 1; }
        (void)hipGetLastError();
        grid = cus;
    }
    if (grid < 0) return;
    Args a{};
    for (int i = 0; i < 30; ++i) a.in[i] = (const float*)d_in[i];
    a.out = (float*)d_out; a.ws = (unsigned char*)d_ws;
    void* args[] = {&a};
    hipError_t e = hipLaunchCooperativeKernel((const void*)fwd_megakernel, dim3(grid), dim3(NTHREADS), args, LDS_BYTES, stream);
    if (e != hipSuccess) fprintf(stderr, "kernel_launch: cooperative launch failed: %s (grid %d)\n", hipGetErrorString(e), grid);
}
```

```cpp
#include <hip/hip_runtime.h>
#include <hip/hip_cooperative_groups.h>
#include <cstdio>
#include <cstdint>
namespace cg = cooperative_groups;
namespace pg8 {
#define PG8_LAS __attribute__((address_space(3)))
typedef unsigned short bf16_t;
typedef short bf16x8 __attribute__((ext_vector_type(8)));
typedef float f32x4 __attribute__((ext_vector_type(4)));
typedef unsigned u32x4 __attribute__((ext_vector_type(4)));
constexpr int BM = 256, BK = 64, HALF = 128, HTB = HALF * BK * 2  , STAGE_BYTES = 8 * HTB, NXCD = 8, WGM = 4;

__host__ __device__ __forceinline__ int lds_byte(int r, int c) { const int st = (r >> 4) * 2 + (c >> 5), rr = r & 15, cc = c & 31, ob = rr * 64 + cc * 2; return st * 1024 + (ob ^ (((ob >> 9) & 1) << 5)); }
__host__ __device__ __forceinline__ void stage_rc(int b, int& R, int& C) { const int st = b / 1024, sb = b % 1024, swz = sb ^ (((sb >> 9) & 1) << 5); R = (st >> 1) * 16 + swz / 64; C = (st & 1) * 32 + (swz % 64) / 2; }
__host__ __device__ __forceinline__ int perm32(int rho) { const int n = rho >> 4, i = rho & 15; return 8 * (i >> 2) + 4 * n + (i & 3); }

struct Unit { int pm, pn, kt0, nkt, pidx; };
struct Gemm { const bf16_t* A; const bf16_t* Bt; int M, N, K; };

struct StaticOrder {
    int nM, nN, nwg, G, c, ntk;
    __host__ __device__ void init(int M, int N, int G_, int c_, int K_) { nM = M / BM; nN = N / BM; nwg = nM * nN; G = G_; c = c_; ntk = K_ / BK; }
    __host__ __device__ bool next(int i, Unit& u) const {
        const long L = (long)i * G + c; if (L >= nwg) return false;
        int wgid = (int)L; { const int q = nwg / NXCD, r = nwg % NXCD, xcd = wgid % NXCD, off = wgid / NXCD; wgid = (xcd < r ? xcd * (q + 1) : r * (q + 1) + (xcd - r) * q) + off; }
        const int nig = WGM * nN, gid = wgid / nig, fm = gid * WGM, gsz = (nM - fm) < WGM ? (nM - fm) : WGM;
        u.pm = fm + ((wgid % nig) % gsz); u.pn = (wgid % nig) / gsz; u.kt0 = 0; u.nkt = ntk; u.pidx = -1; return true;
    }
    __device__ __forceinline__ void a_ready(const Unit&) const {}
    __device__ __forceinline__ void done(const Unit&) const {}
};

struct TailSplitOrder {
    int nN, ntu, G, v, R, nT, split;
    __host__ __device__ void init(int M, int N, int K, int G_, int v_) {
        nN = N / BM; ntu = K / BK; G = G_; v = v_; const int nu = (M / BM) * nN; R = nu / G; nT = nu - R * G; split = 1;
        if (nT > 0 && G % nT == 0 && ntu % (G / nT) == 0 && ((ntu / (G / nT)) & 1) == 0 && ntu / (G / nT) >= 4) split = G / nT;
    }
    __host__ __device__ int tail_pm0() const { return (R * G) / nN; }
    __host__ __device__ bool next(int i, Unit& u) const {
        if (i < R) { const int t = i * G + v; u.pm = t / nN; u.pn = t - u.pm * nN; u.kt0 = 0; u.nkt = ntu; u.pidx = -1; return true; }
        if (i > R || nT == 0) return false;
        if (split == 1) { if (v >= nT) return false; const int t = R * G + v; u.pm = t / nN; u.pn = t - u.pm * nN; u.kt0 = 0; u.nkt = ntu; u.pidx = -1; return true; }
        const int pn = v % nN, q = (v / nN) % split, pl = v / (nN * split), l = pl * nN + pn, t = R * G + l;
        u.pm = t / nN; u.pn = t - u.pm * nN; u.nkt = ntu / split; u.kt0 = q * u.nkt; u.pidx = q == 0 ? -1 : l * (split - 1) + q - 1; return true;
    }
    __device__ __forceinline__ void a_ready(const Unit&) const {}
    __device__ __forceinline__ void done(const Unit&) const {}
};

__device__ __forceinline__ unsigned cvt_pk_bf16(float lo, float hi) { unsigned r; asm volatile("v_cvt_pk_bf16_f32 %0, %1, %2" : "=v"(r) : "v"(lo), "v"(hi)); return r; }
typedef float f32x2 __attribute__((ext_vector_type(2)));
template <class Epi, class Sched, bool ALIGN_EPI = false, bool SP2 = false>
__device__ __forceinline__ void gemm_phase(PG8_LAS unsigned char* lds, const Gemm g, const Sched& S, const Epi& E) {
    int tid_ = threadIdx.x; asm volatile("" : "+v"(tid_));
    const int tid = tid_, wid = __builtin_amdgcn_readfirstlane(tid >> 6), lane = tid & 63, wr = wid >> 2, wc = wid & 3, fr = lane & 15, fq = lane >> 4;
    const int K = g.K, nt = K / BK;
    unsigned voffA[2], voffB[2];
#pragma unroll
    for (int i = 0; i < 2; ++i) { int R, C; stage_rc(tid * 16 + i * 8192, R, C); const int Rb = Epi::PERM ? ((R & ~31) + perm32(R & 31)) : R;
        voffA[i] = (unsigned)(R * K + C) * 2u; voffB[i] = (unsigned)(Rb * K + C) * 2u; }
    const size_t kstep = (size_t)(BK * 2);
    const size_t hstep = (size_t)HALF * K * 2;
    const size_t tstep = 2 * hstep;
    const unsigned ldsw = (unsigned)wid * 1024u;
    const int aoff = lds_byte(wr * 64 + fr, fq * 8), boff = lds_byte(wc * 32 + fr, fq * 8);
#define PG8_SA(b, h) (((b) * 2 + (h)) * HTB)
#define PG8_SB(b, h) ((4 + (b) * 2 + (h)) * HTB)
#define PG8_STAGE(bufoff, gbase, voff) do { _Pragma("unroll") for (int _i = 0; _i < 2; ++_i) \
        __builtin_amdgcn_global_load_lds((const unsigned*)((const char*)(gbase) + (voff)[_i]), (PG8_LAS unsigned*)(lds + (bufoff) + ldsw + _i * 8192), 16, 0, 0); } while (0)
#define PG8_LDA(dst, b, h) do { _Pragma("unroll") for (int m = 0; m < 4; ++m) _Pragma("unroll") for (int k = 0; k < 2; ++k) dst[m][k] = *(const PG8_LAS bf16x8*)(lds + PG8_SA(b, h) + aoff + m * 2048 + k * 1024); } while (0)
#define PG8_LDB(dst, b, h) do { _Pragma("unroll") for (int n = 0; n < 2; ++n) _Pragma("unroll") for (int k = 0; k < 2; ++k) dst[n][k] = *(const PG8_LAS bf16x8*)(lds + PG8_SB(b, h) + boff + n * 2048 + k * 1024); } while (0)
#define PG8_MMA(ai, bj, At, Bt) do { __builtin_amdgcn_s_setprio(1); _Pragma("unroll") for (int m = 0; m < 4; ++m) _Pragma("unroll") for (int n = 0; n < 2; ++n) _Pragma("unroll") for (int k = 0; k < 2; ++k) \
        acc[ai][bj][m][n] = __builtin_amdgcn_mfma_f32_16x16x32_bf16(Bt[n][k], At[m][k], acc[ai][bj][m][n], 0, 0, 0); __builtin_amdgcn_s_setprio(0); } while (0)
#define PG8_WAIT_V(n) asm volatile("s_waitcnt vmcnt(" #n ")" ::: "memory")
#define PG8_WAIT_L(n) asm volatile("s_waitcnt lgkmcnt(" #n ")" ::: "memory")
#define PG8_BAR __builtin_amdgcn_s_barrier()
#define PG8_SCHED __builtin_amdgcn_sched_barrier(0)
    Unit cur, nxt; int ui = 0;
    if (!S.next(0, cur)) return;
    f32x4 acc[2][2][4][2];
#pragma unroll
    for (int a = 0; a < 2; ++a)
#pragma unroll
        for (int b = 0; b < 2; ++b)
#pragma unroll
            for (int m = 0; m < 4; ++m)
#pragma unroll
                for (int n = 0; n < 2; ++n) acc[a][b][m][n] = (f32x4){0.f, 0.f, 0.f, 0.f};
    bf16x8 At[4][2], B0[2][2], B1[2][2];
    const char* cA = (const char*)g.A + (size_t)cur.pm * tstep + (size_t)cur.kt0 * kstep; const char* cB = (const char*)g.Bt + (size_t)cur.pn * tstep + (size_t)cur.kt0 * kstep;
    S.a_ready(cur);
    if constexpr (SP2) {
        PG8_STAGE(PG8_SB(0, 0), cB, voffB); PG8_STAGE(PG8_SB(0, 1), cB + hstep, voffB); PG8_STAGE(PG8_SA(0, 0), cA, voffA); PG8_STAGE(PG8_SA(0, 1), cA + hstep, voffA);
        if (wr == 1) PG8_BAR;
        PG8_WAIT_V(2); PG8_BAR;
        PG8_STAGE(PG8_SB(1, 0), cB + kstep, voffB); PG8_STAGE(PG8_SA(1, 0), cA + kstep, voffA); PG8_STAGE(PG8_SB(1, 1), cB + hstep + kstep, voffB);
        PG8_WAIT_V(6); PG8_BAR;
    } else {
        PG8_STAGE(PG8_SB(0, 0), cB, voffB); PG8_STAGE(PG8_SA(0, 0), cA, voffA); PG8_STAGE(PG8_SB(0, 1), cB + hstep, voffB); PG8_STAGE(PG8_SA(0, 1), cA + hstep, voffA);
        if (wr == 1) PG8_BAR;
        PG8_WAIT_V(4); PG8_BAR;
        PG8_STAGE(PG8_SB(1, 0), cB + kstep, voffB); PG8_STAGE(PG8_SA(1, 0), cA + kstep, voffA); PG8_STAGE(PG8_SB(1, 1), cB + hstep + kstep, voffB);
        PG8_WAIT_V(6); PG8_BAR;
    }
    for (;;) {
        const bool has_next = S.next(ui + 1, nxt);
        const char* nA = has_next ? (const char*)g.A + (size_t)nxt.pm * tstep + (size_t)nxt.kt0 * kstep : cA; const char* nB = has_next ? (const char*)g.Bt + (size_t)nxt.pn * tstep + (size_t)nxt.kt0 * kstep : cB;
        const int cnt = cur.nkt;
        for (int t = 0; t < cnt; t += 2) {
            const bool last = (t == cnt - 2);
            const char* a1 = cA + (size_t)(t + 1) * kstep;
            const char* a2 = last ? nA : cA + (size_t)(t + 2) * kstep; const char* b2 = last ? nB : cB + (size_t)(t + 2) * kstep;
            const char* a3 = a2 + kstep; const char* b3 = b2 + kstep;
            if (last && has_next) S.a_ready(nxt);
            if constexpr (Epi::HAS_MID) { if (t == (nt >> 1)) E.mid(acc, cur, wr, wc, fr, fq); }
            if constexpr (SP2) {
            PG8_LDB(B0, 0, 0); PG8_LDB(B1, 0, 1); PG8_SCHED; PG8_LDA(At, 0, 0); PG8_STAGE(PG8_SA(1, 1), a1 + hstep, voffA);
            PG8_WAIT_V(8); PG8_WAIT_L(0); PG8_BAR; PG8_MMA(0, 0, At, B0); PG8_MMA(0, 1, At, B1); PG8_BAR; PG8_SCHED;
            PG8_LDA(At, 0, 1); PG8_STAGE(PG8_SB(0, 0), b2, voffB); PG8_STAGE(PG8_SB(0, 1), b2 + hstep, voffB); PG8_STAGE(PG8_SA(0, 0), a2, voffA);
            PG8_WAIT_V(8); PG8_WAIT_L(0); PG8_BAR; PG8_MMA(1, 0, At, B0); PG8_MMA(1, 1, At, B1); PG8_BAR; PG8_SCHED;
            PG8_LDB(B0, 1, 0); PG8_LDB(B1, 1, 1); PG8_SCHED; PG8_LDA(At, 1, 0); PG8_STAGE(PG8_SA(0, 1), a2 + hstep, voffA);
            PG8_WAIT_V(8); PG8_WAIT_L(0); PG8_BAR; PG8_MMA(0, 0, At, B0); PG8_MMA(0, 1, At, B1); PG8_BAR; PG8_SCHED;
            PG8_LDA(At, 1, 1); PG8_STAGE(PG8_SB(1, 0), b3, voffB); PG8_STAGE(PG8_SB(1, 1), b3 + hstep, voffB); PG8_STAGE(PG8_SA(1, 0), a3, voffA);
            PG8_WAIT_V(8); PG8_WAIT_L(0); PG8_BAR; PG8_MMA(1, 0, At, B0); PG8_MMA(1, 1, At, B1); PG8_BAR; PG8_SCHED;
            } else {
            PG8_LDB(B0, 0, 0); PG8_SCHED; PG8_LDA(At, 0, 0); PG8_STAGE(PG8_SA(1, 1), a1 + hstep, voffA);
            PG8_WAIT_L(8); PG8_BAR; PG8_WAIT_L(0); PG8_MMA(0, 0, At, B0); PG8_BAR; PG8_SCHED;
            PG8_LDB(B1, 0, 1); PG8_STAGE(PG8_SB(0, 0), b2, voffB);
            PG8_BAR; PG8_WAIT_L(0); PG8_MMA(0, 1, At, B1); PG8_BAR;
            PG8_LDA(At, 0, 1); PG8_STAGE(PG8_SA(0, 0), a2, voffA);
            PG8_BAR; PG8_WAIT_L(0); PG8_MMA(1, 0, At, B0); PG8_BAR; PG8_SCHED;
            PG8_STAGE(PG8_SB(0, 1), b2 + hstep, voffB);
            PG8_WAIT_V(6); PG8_BAR; PG8_MMA(1, 1, At, B1); PG8_BAR;
            PG8_LDB(B0, 1, 0); PG8_SCHED; PG8_LDA(At, 1, 0); PG8_STAGE(PG8_SA(0, 1), a2 + hstep, voffA);
            PG8_WAIT_L(8); PG8_BAR; PG8_WAIT_L(0); PG8_MMA(0, 0, At, B0); PG8_BAR; PG8_SCHED;
            PG8_LDB(B1, 1, 1); PG8_STAGE(PG8_SB(1, 0), b3, voffB);
            PG8_BAR; PG8_WAIT_L(0); PG8_MMA(0, 1, At, B1); PG8_BAR;
            PG8_LDA(At, 1, 1); PG8_STAGE(PG8_SA(1, 0), a3, voffA);
            PG8_BAR; PG8_WAIT_L(0); PG8_MMA(1, 0, At, B0); PG8_BAR; PG8_SCHED;
            PG8_STAGE(PG8_SB(1, 1), b3 + hstep, voffB);
            PG8_WAIT_V(6); PG8_BAR; PG8_MMA(1, 1, At, B1); PG8_BAR;
            }
        }
        if constexpr (ALIGN_EPI) { if (wr == 0) PG8_BAR; }
        if constexpr (!Epi::AFTER_DRAIN) { E(acc, cur, wr, wc, fr, fq); S.done(cur); }
        if (!has_next) break;
#pragma unroll
        for (int a = 0; a < 2; ++a)
#pragma unroll
            for (int b = 0; b < 2; ++b)
#pragma unroll
                for (int m = 0; m < 4; ++m)
#pragma unroll
                    for (int n = 0; n < 2; ++n) acc[a][b][m][n] = (f32x4){0.f, 0.f, 0.f, 0.f};
        cur = nxt; cA = nA; cB = nB; ++ui;
        if constexpr (ALIGN_EPI) { if (wr == 1) PG8_BAR; }
    }
    PG8_WAIT_V(0);
    if constexpr (!ALIGN_EPI) { if (wr == 0) PG8_BAR; }
    PG8_BAR;
    if constexpr (Epi::AFTER_DRAIN) { E.fused(acc, cur, wr, wc, fr, fq, lds, wid, lane); S.done(cur); }
#undef PG8_SA
#undef PG8_SB
#undef PG8_STAGE
#undef PG8_LDA
#undef PG8_LDB
#undef PG8_MMA
#undef PG8_WAIT_V
#undef PG8_WAIT_L
#undef PG8_BAR
#undef PG8_SCHED
}
}

#define LAS __attribute__((address_space(3)))
typedef unsigned short bf16;
typedef short bf16x8 __attribute__((ext_vector_type(8)));
typedef float f32x4 __attribute__((ext_vector_type(4)));
typedef float f32x2 __attribute__((ext_vector_type(2)));
typedef unsigned u32x4 __attribute__((ext_vector_type(4)));
typedef unsigned u32x2 __attribute__((ext_vector_type(2)));

constexpr int DM = 2048, DFF = 5632, DRNN = 1024, NHEAD = 8;
constexpr int MP = 8192, MS = 2048, MT = MP + MS;
constexpr int SEQ = 2048, DSEQ = 64, NB = 4, NSB = 32;
constexpr int ZM_LD = 6144, ZG_LD = 4096;
constexpr float DN_ALPHA = 1.189207115002721f;
constexpr int NPOS = 2112;
constexpr int NWAVES = 8, NTHREADS = 512;
constexpr int LDS_BYTES = 147456;

constexpr size_t WS_TAB = 65536;
constexpr size_t WS_GATEW = WS_TAB + 1310720;
constexpr size_t WS_WGU = WS_GATEW + 262144;
constexpr size_t WS_WD = WS_WGU + (size_t)2 * DFF * DM * 2;
constexpr size_t WS_WIN = WS_WD + (size_t)DM * DFF * 2;
constexpr size_t WS_WAB = WS_WIN + (size_t)10240 * DM * 2;
constexpr size_t WS_WO = WS_WAB + (size_t)DM * DM * 2;
constexpr size_t WS_XNB = WS_WO + (size_t)DM * DM * 2;
constexpr size_t WS_X1 = WS_XNB + (size_t)MT * DM * 2;
constexpr size_t WS_H = WS_X1 + (size_t)MT * DM * 4;
constexpr size_t WS_T = WS_H + (size_t)MT * ZM_LD * 2;
constexpr size_t WS_END = WS_T + (size_t)MT * DM * 4;
static_assert(WS_WIN + (size_t)MT * DM * 4 <= WS_X1, "stream-K second buffer of the last down GEMM");
static_assert(WS_WGU + ((size_t)MT * DRNN + (size_t)NB * NHEAD * 8 * 16384 + (size_t)360 * DRNN * 2) * 4 <= WS_WIN, "mixer scratch fits the FFN weight region");
static_assert(1081344 + (size_t)MT * 2 * 4 * 2 <= 1310720, "row statistics fit behind the rotary table");
static_assert(WS_END <= 496066560, "workspace map exceeds the guaranteed ws_size");

constexpr size_t O_Y = 0;
constexpr size_t O_CONVP = (size_t)MT * DM;
constexpr size_t O_LRUP = O_CONVP + (size_t)NB * 3 * DRNN;
constexpr size_t O_RETP = O_LRUP + (size_t)NB * DRNN;
constexpr size_t O_CONVS = O_RETP + (size_t)NB * NHEAD * 16384;
constexpr size_t O_LRUS = O_CONVS + (size_t)NSB * 3 * DRNN;
constexpr size_t O_RETS = O_LRUS + (size_t)NSB * DRNN;

__device__ __forceinline__ float bflo(unsigned w) { return __uint_as_float(w << 16); }
__device__ __forceinline__ float bfhi(unsigned w) { return __uint_as_float(w & 0xffff0000u); }
__device__ __forceinline__ float bf2f(bf16 b) { return __uint_as_float((unsigned)b << 16); }
__device__ __forceinline__ unsigned f2bf(float f) { unsigned u = __float_as_uint(f); return (u + 0x7fffu + ((u >> 16) & 1u)) >> 16; }
__device__ __forceinline__ unsigned pk2(float lo, float hi) { return pg8::cvt_pk_bf16(lo, hi); }
__device__ __forceinline__ float fast_exp(float x) { return __builtin_amdgcn_exp2f(x * 1.4426950408889634f); }
__device__ __forceinline__ float fast_sigmoid(float x) { return __builtin_amdgcn_rcpf(1.0f + fast_exp(-x)); }
__device__ __forceinline__ float wave_sum(float v) {
#pragma unroll
    for (int o = 1; o < 64; o <<= 1) v += __shfl_xor(v, o);
    return v;
}
#define MFMA16(a, b, c) __builtin_amdgcn_mfma_f32_16x16x32_bf16((a), (b), (c), 0, 0, 0)

struct EpiSwiglu {
    static constexpr bool PERM = true, AFTER_DRAIN = false, HAS_MID = false;
    bf16* H;
    __device__ __forceinline__ void mid(f32x4 (&)[2][2][4][2], const pg8::Unit&, int, int, int, int) const {}
    __device__ __forceinline__ void operator()(const f32x4 (&acc)[2][2][4][2], const pg8::Unit& u, int wr, int wc, int fr, int fq) const {
        const int row0 = u.pm * 256 + wr * 64 + fr, col0 = u.pn * 128 + wc * 32 + 8 * fq;
#pragma unroll
        for (int ai = 0; ai < 2; ++ai)
#pragma unroll
            for (int m = 0; m < 4; ++m) {
                bf16* rowp = H + (size_t)(row0 + ai * 128 + m * 16) * DFF + col0;
                float v[8];
#pragma unroll
                for (int n = 0; n < 2; ++n)
#pragma unroll
                    for (int j = 0; j < 4; ++j) { const float g = acc[ai][0][m][n][j], up = acc[ai][1][m][n][j]; v[n * 4 + j] = g * fast_sigmoid(g) * up; }
                u32x4 w; w.x = pk2(v[0], v[1]); w.y = pk2(v[2], v[3]); w.z = pk2(v[4], v[5]); w.w = pk2(v[6], v[7]);
                *(u32x4*)rowp = w;
            }
    }
};
template <bool LNRES, bool HALFS> struct EpiRes {
    static constexpr bool PERM = true, AFTER_DRAIN = false, HAS_MID = false;
    const bf16* RB;
    bf16* T; bf16* P; const float* st; const float* lg; const float* lb;
    __device__ __forceinline__ void mid(f32x4 (&)[2][2][4][2], const pg8::Unit&, int, int, int, int) const {}
    __device__ __forceinline__ void operator()(const f32x4 (&acc)[2][2][4][2], const pg8::Unit& u, int wr, int wc, int fr, int fq) const {
        asm volatile("" : "+v"(fr));
        const int row0 = u.pm * 256 + wr * 64 + fr, col0 = u.pn * 256 + wc * 32 + 8 * fq;
        constexpr float alpha = DN_ALPHA, scale = HALFS ? 0.5f : 1.0f;
        constexpr int NG = 4;
        f32x4 gv[2][2], bv[2][2];
        if constexpr (LNRES) {
            const float* lgp = lg + col0; const float* lbp = lb + col0;
            asm volatile("" : "+v"(lgp), "+v"(lbp));
#pragma unroll
            for (int bj = 0; bj < 2; ++bj)
#pragma unroll
                for (int n = 0; n < 2; ++n) { gv[bj][n] = *(const f32x4*)(lgp + bj * 128 + n * 4); bv[bj][n] = *(const f32x4*)(lbp + bj * 128 + n * 4); }
        }
#pragma unroll
        for (int ai = 0; ai < 2; ++ai)
#pragma unroll
            for (int mp = 0; mp < 4 / NG; ++mp) {
                if (u.pidx >= 0) {
#pragma unroll
                    for (int mq = 0; mq < NG; ++mq)
#pragma unroll
                        for (int bj = 0; bj < 2; ++bj) { const int m = mp * NG + mq; const f32x4 o0 = acc[ai][bj][m][0] * scale, o1 = acc[ai][bj][m][1] * scale;
                            u32x4 w; w.x = pk2(o0.x, o0.y); w.y = pk2(o0.z, o0.w); w.z = pk2(o1.x, o1.y); w.w = pk2(o1.z, o1.w);
                            *(u32x4*)(P + (size_t)u.pidx * 65536 + (size_t)(wr * 64 + fr + ai * 128 + m * 16) * 256 + wc * 32 + 8 * fq + bj * 128) = w; }
                } else {
                    u32x4 rb[NG][2]; f32x2 ms[NG];
#pragma unroll
                    for (int mq = 0; mq < NG; ++mq) { const int m = mp * NG + mq; const size_t off = (size_t)(row0 + ai * 128 + m * 16) * DM + col0;
                        if constexpr (LNRES) ms[mq] = *(const f32x2*)(st + (size_t)(row0 + ai * 128 + m * 16) * 2);
#pragma unroll
                        for (int bj = 0; bj < 2; ++bj) rb[mq][bj] = *(const u32x4*)(RB + off + bj * 128); }
#pragma unroll
                    for (int mq = 0; mq < NG; ++mq) { const int m = mp * NG + mq; const size_t off = (size_t)(row0 + ai * 128 + m * 16) * DM + col0;
#pragma unroll
                        for (int bj = 0; bj < 2; ++bj) { const u32x4 q = rb[mq][bj];
                            f32x4 x0 = (f32x4){bflo(q.x), bfhi(q.x), bflo(q.y), bfhi(q.y)}, x1 = (f32x4){bflo(q.z), bfhi(q.z), bflo(q.w), bfhi(q.w)};
                            if constexpr (LNRES) { x0 = (x0 - ms[mq].x) * ms[mq].y * gv[bj][0] + bv[bj][0]; x1 = (x1 - ms[mq].x) * ms[mq].y * gv[bj][1] + bv[bj][1]; }
                            const f32x4 o0 = x0 * alpha + acc[ai][bj][m][0] * scale, o1 = x1 * alpha + acc[ai][bj][m][1] * scale;
                            u32x4 w; w.x = pk2(o0.x, o0.y); w.y = pk2(o0.z, o0.w); w.z = pk2(o1.x, o1.y); w.w = pk2(o1.z, o1.w);
                            *(u32x4*)(T + off + bj * 128) = w; } }
                }
                asm volatile("" ::: "memory");
            }
    }
};
struct EpiZ {
    static constexpr bool PERM = true, AFTER_DRAIN = false, HAS_MID = false;
    bf16* Zm; bf16* Zg;
    __device__ __forceinline__ void mid(f32x4 (&)[2][2][4][2], const pg8::Unit&, int, int, int, int) const {}
    __device__ __forceinline__ void operator()(const f32x4 (&acc)[2][2][4][2], const pg8::Unit& u, int wr, int wc, int fr, int fq) const {
        const int row0 = u.pm * 256 + wr * 64 + fr; int colt = u.pn * 256; bf16* base = Zm; int ld = ZM_LD;
        if (colt >= ZM_LD) { colt -= ZM_LD; base = Zg; ld = ZG_LD; }
        const int col0 = colt + wc * 32 + 8 * fq;
#pragma unroll
        for (int ai = 0; ai < 2; ++ai)
#pragma unroll
            for (int m = 0; m < 4; ++m) {
                bf16* rowp = base + (size_t)(row0 + ai * 128 + m * 16) * ld + col0;
#pragma unroll
                for (int bj = 0; bj < 2; ++bj) {
                    const f32x4 v0 = acc[ai][bj][m][0], v1 = acc[ai][bj][m][1];
                    u32x4 w; w.x = pk2(v0[0], v0[1]); w.y = pk2(v0[2], v0[3]); w.z = pk2(v1[0], v1[1]); w.w = pk2(v1[2], v1[3]);
                    *(u32x4*)(rowp + bj * 128) = w;
                }
            }
    }
};
struct EpiMerge {
    static constexpr bool PERM = true, AFTER_DRAIN = false, HAS_MID = true;
    const bf16* Zg; bf16* MG;
    __device__ __forceinline__ void mid(f32x4 (&acc)[2][2][4][2], const pg8::Unit& u, int wr, int wc, int fr, int fq) const {
        int row0 = u.pm * 256 + wr * 64 + fr; const int col0 = u.pn * 256 + wc * 32 + 8 * fq;
        asm volatile("" : "+v"(row0));
#pragma unroll
        for (int ai = 0; ai < 2; ++ai) {
            u32x4 ga[4][2], gb[4][2];
#pragma unroll
            for (int m = 0; m < 4; ++m) { const bf16* rowp = Zg + (size_t)(row0 + ai * 128 + m * 16) * ZG_LD + col0;
#pragma unroll
                for (int bj = 0; bj < 2; ++bj) { ga[m][bj] = *(const u32x4*)(rowp + bj * 128); gb[m][bj] = *(const u32x4*)(rowp + 2048 + bj * 128); } }
#pragma unroll
            for (int m = 0; m < 4; ++m)
#pragma unroll
                for (int bj = 0; bj < 2; ++bj) {
                    const unsigned gaw[4] = {ga[m][bj].x, ga[m][bj].y, ga[m][bj].z, ga[m][bj].w}, gbw[4] = {gb[m][bj].x, gb[m][bj].y, gb[m][bj].z, gb[m][bj].w};
#pragma unroll
                    for (int q = 0; q < 4; ++q) {
                        const float a0 = bflo(gaw[q]), a1 = bfhi(gaw[q]), b0 = bflo(gbw[q]), b1 = bfhi(gbw[q]);
                        const float f0 = (1.0f + fast_exp(-b0)) * __builtin_amdgcn_rcpf(1.0f + fast_exp(-a0));
                        const float f1 = (1.0f + fast_exp(-b1)) * __builtin_amdgcn_rcpf(1.0f + fast_exp(-a1));
                        acc[ai][bj][m][q >> 1][(q & 1) * 2 + 0] *= f0; acc[ai][bj][m][q >> 1][(q & 1) * 2 + 1] *= f1;
                    }
                }
            asm volatile("" ::: "memory");
        }
    }
    __device__ __forceinline__ void operator()(const f32x4 (&acc)[2][2][4][2], const pg8::Unit& u, int wr, int wc, int fr, int fq) const {
        asm volatile("" : "+v"(fr));
        const int row0 = u.pm * 256 + wr * 64 + fr, col0 = u.pn * 256 + wc * 32 + 8 * fq;
#pragma unroll
        for (int ai = 0; ai < 2; ++ai) {
            u32x4 gb[4][2];
#pragma unroll
            for (int m = 0; m < 4; ++m)
#pragma unroll
                for (int bj = 0; bj < 2; ++bj) gb[m][bj] = *(const u32x4*)(Zg + (size_t)(row0 + ai * 128 + m * 16) * ZG_LD + 2048 + col0 + bj * 128);
#pragma unroll
            for (int m = 0; m < 4; ++m) {
                const size_t r = (size_t)(row0 + ai * 128 + m * 16);
#pragma unroll
                for (int bj = 0; bj < 2; ++bj) {
                    const unsigned gbw[4] = {gb[m][bj].x, gb[m][bj].y, gb[m][bj].z, gb[m][bj].w};
                    float v[8];
#pragma unroll
                    for (int q = 0; q < 4; ++q) {
                        v[2 * q] = acc[ai][bj][m][q >> 1][(q & 1) * 2] * fast_sigmoid(bflo(gbw[q]));
                        v[2 * q + 1] = acc[ai][bj][m][q >> 1][(q & 1) * 2 + 1] * fast_sigmoid(bfhi(gbw[q]));
                    }
                    u32x4 w; w.x = pk2(v[0], v[1]); w.y = pk2(v[2], v[3]); w.z = pk2(v[4], v[5]); w.w = pk2(v[6], v[7]);
                    *(u32x4*)(MG + r * DM + col0 + bj * 128) = w;
                }
            }
            asm volatile("" ::: "memory");
        }
    }
};

__device__ __forceinline__ void tr_item(const float* __restrict__ W, int N, int k0, int n0, bf16* WT, size_t drow0, int ldk, int koff, LAS float* scr, int lane) {
#pragma unroll 8
    for (int i = 0; i < 32; ++i) { const int kk = 2 * i + (lane >> 5); scr[kk * 33 + (lane & 31)] = W[(size_t)(k0 + kk) * N + n0 + (lane & 31)]; }
    asm volatile("s_waitcnt lgkmcnt(0)" ::: "memory");
    const int c = lane & 7;
#pragma unroll
    for (int j = 0; j < 4; ++j) {
        const int n = (lane >> 3) + 8 * j; const LAS float* s = scr + (8 * c) * 33 + n;
        u32x4 o; o.x = pk2(s[0 * 33], s[1 * 33]); o.y = pk2(s[2 * 33], s[3 * 33]); o.z = pk2(s[4 * 33], s[5 * 33]); o.w = pk2(s[6 * 33], s[7 * 33]);
        *(u32x4*)(WT + (drow0 + n) * (size_t)ldk + koff + k0 + 8 * c) = o;
    }
    asm volatile("s_waitcnt lgkmcnt(0)" ::: "memory");
}
__device__ __forceinline__ void conv_mat(const float* W, int K, int N, bf16* WT, int ldk, int koff, int mode, int gw, int ngw, LAS float* scr, int lane) {
    asm volatile("" : "+v"(lane));
    const int nblk = N / 32, items = (K / 64) * nblk;
    float cur[32], nxt[32];
    int it = gw;
    if (it < items) { const int kb = it / nblk, nb = it - kb * nblk; const float* src = W + (size_t)(kb * 64 + (lane >> 5)) * N + nb * 32 + (lane & 31);
#pragma unroll
        for (int i = 0; i < 32; ++i) cur[i] = src[(size_t)(2 * i) * N]; }
    for (; it < items; it += ngw) {
        const int kb = it / nblk, nb = it - kb * nblk, n0 = nb * 32, k0 = kb * 64;
        const size_t drow0 = mode == 0 ? (size_t)n0 : (size_t)((n0 >> 7) * 256 + (n0 & 127) + (mode == 2 ? 128 : 0));
        const int itn = it + ngw;
        if (itn < items) { const int kbn = itn / nblk, nbn = itn - kbn * nblk; const float* src = W + (size_t)(kbn * 64 + (lane >> 5)) * N + nbn * 32 + (lane & 31);
#pragma unroll
            for (int i = 0; i < 32; ++i) nxt[i] = src[(size_t)(2 * i) * N]; }
#pragma unroll
        for (int i = 0; i < 32; ++i) scr[(2 * i + (lane >> 5)) * 33 + (lane & 31)] = cur[i];
        asm volatile("s_waitcnt lgkmcnt(0)" ::: "memory");
        const int c = lane & 7;
#pragma unroll
        for (int j = 0; j < 4; ++j) {
            const int n = (lane >> 3) + 8 * j; const LAS float* sp = scr + (8 * c) * 33 + n;
            u32x4 o; o.x = pk2(sp[0 * 33], sp[1 * 33]); o.y = pk2(sp[2 * 33], sp[3 * 33]); o.z = pk2(sp[4 * 33], sp[5 * 33]); o.w = pk2(sp[6 * 33], sp[7 * 33]);
            *(u32x4*)(WT + (drow0 + n) * (size_t)ldk + koff + k0 + 8 * c) = o;
        }
        asm volatile("s_waitcnt lgkmcnt(0)" ::: "memory");
#pragma unroll
        for (int i = 0; i < 32; ++i) cur[i] = nxt[i];
    }
}
__device__ __forceinline__ void ln_rows(bf16* T, const bf16* P, int tail_pm0, int nparts, const float* g, const float* b, float* Xf, bf16* Xb, float* st, int gw, int ngw, int lane) {
    asm volatile("" : "+v"(lane));
    f32x4 gg[8], bb[8], v[8]; u32x2 cur[8], nx[8];
#pragma unroll
    for (int j = 0; j < 8; ++j) { gg[j] = ((const f32x4*)g)[64 * j + lane]; bb[j] = ((const f32x4*)b)[64 * j + lane]; }
    int m = gw;
    if (m < MT) {
#pragma unroll
        for (int j = 0; j < 8; ++j) cur[j] = ((const u32x2*)(T + (size_t)m * DM))[64 * j + lane];
    }
    for (; m < MT; m += ngw) {
        const int mn = m + ngw;
        if (mn < MT) {
#pragma unroll
            for (int j = 0; j < 8; ++j) nx[j] = ((const u32x2*)(T + (size_t)mn * DM))[64 * j + lane];
        }
#pragma unroll
        for (int j = 0; j < 8; ++j) v[j] = (f32x4){bflo(cur[j].x), bfhi(cur[j].x), bflo(cur[j].y), bfhi(cur[j].y)};
        float s = 0.f;
        if (nparts > 0 && (m >> 8) >= tail_pm0) {
            for (int q = 0; q < nparts; ++q)
#pragma unroll
                for (int j = 0; j < 8; ++j) { const u32x2 p = *(const u32x2*)(P + (size_t)((((m >> 8) - tail_pm0) * 8 + j) * nparts + q) * 65536 + (size_t)(m & 255) * 256 + lane * 4);
                    v[j] += (f32x4){bflo(p.x), bfhi(p.x), bflo(p.y), bfhi(p.y)}; }
            if (st) {
#pragma unroll
                for (int j = 0; j < 8; ++j) { u32x2 w; w.x = pk2(v[j].x, v[j].y); w.y = pk2(v[j].z, v[j].w); ((u32x2*)(T + (size_t)m * DM))[64 * j + lane] = w;
                    v[j] = (f32x4){bflo(w.x), bfhi(w.x), bflo(w.y), bfhi(w.y)}; }
            }
        }
#pragma unroll
        for (int j = 0; j < 8; ++j) s += (v[j].x + v[j].y) + (v[j].z + v[j].w);
        const float mean = wave_sum(s) * (1.f / DM); float s2 = 0.f;
#pragma unroll
        for (int j = 0; j < 8; ++j) { v[j] = v[j] - mean; s2 += (v[j].x * v[j].x + v[j].y * v[j].y) + (v[j].z * v[j].z + v[j].w * v[j].w); }
        const float rstd = 1.0f / sqrtf(wave_sum(s2) * (1.f / DM) + 1e-5f);
        if (st && lane == 0) *(f32x2*)(st + (size_t)m * 2) = (f32x2){mean, rstd};
#pragma unroll
        for (int j = 0; j < 8; ++j) {
            const f32x4 o = v[j] * rstd * gg[j] + bb[j];
            if (Xf) ((f32x4*)(Xf + (size_t)m * DM))[64 * j + lane] = o;
            if (Xb) { u32x2 w; w.x = pk2(o.x, o.y); w.y = pk2(o.z, o.w); ((u32x2*)(Xb + (size_t)m * DM))[64 * j + lane] = w; }
        }
#pragma unroll
        for (int j = 0; j < 8; ++j) cur[j] = nx[j];
    }
}

constexpr int R_QS = 0, R_KS = 18432, R_KT = 36864, R_VT = 57344, R_SS = 77824, R_STB = 88064, R_GNX = 124928;
static_assert(R_GNX + 1024 <= 131072, "retention LDS map");
#define LDS_BARRIER() do { asm volatile("s_waitcnt lgkmcnt(0)" ::: "memory"); __builtin_amdgcn_s_barrier(); asm volatile("" ::: "memory"); } while (0)
template <bool STATE_ONLY>
__device__ __forceinline__ void ret_item(LAS unsigned char* lds, const bf16* __restrict__ Zm, int row0, int nchunks, int pos0, int h,
                                         const float* __restrict__ Sf, int nfold, float fdec, float* Sout, const float* __restrict__ tab,
                                         const float* __restrict__ gng, const float* __restrict__ gnb, bf16* Y) {
    const int tid = threadIdx.x, lane = tid & 63, w = __builtin_amdgcn_readfirstlane(tid >> 6), fr = lane & 15, fq = lane >> 4;
    const float log2g = log2f(1.0f - exp2f(-5.0f - (float)h));
    const float cdec = exp2f(64.0f * log2g);
    f32x4 S[8];
#pragma unroll
    for (int nt = 0; nt < 8; ++nt) S[nt] = (f32x4){0.f, 0.f, 0.f, 0.f};
    if (nfold > 0) {
        f32x4 fa[8];
#pragma unroll
        for (int k = 0; k < 8; ++k) fa[k] = (f32x4){0.f, 0.f, 0.f, 0.f};
        for (int j = 0; j < nfold; j += 4) {
            f32x4 ld[4][8];
#pragma unroll
            for (int u = 0; u < 4; ++u)
#pragma unroll
                for (int k = 0; k < 8; ++k) ld[u][k] = (j + u < nfold) ? *((const f32x4*)(Sf + (size_t)(j + u) * 16384) + tid + 512 * k) : (f32x4){0.f, 0.f, 0.f, 0.f};
#pragma unroll
            for (int u = 0; u < 4; ++u) if (j + u < nfold) {
#pragma unroll
                for (int k = 0; k < 8; ++k) fa[k] = fa[k] * fdec + ld[u][k];
            }
        }
#pragma unroll
        for (int k = 0; k < 8; ++k) { const int e = (tid + 512 * k) * 4, dk = e >> 7, dv = e & 127; *(LAS f32x4*)(lds + (dk * 132 + dv) * 4) = fa[k]; }
        LDS_BARRIER();
#pragma unroll
        for (int nt = 0; nt < 8; ++nt)
#pragma unroll
            for (int r = 0; r < 4; ++r) S[nt][r] = *(const LAS float*)(lds + ((nt * 16 + 4 * fq + r) * 132 + 16 * w + fr) * 4);
        LDS_BARRIER();
    }
    const int mt = w >> 1, wh = w & 1, j0 = w * 8;
    const float kdec = exp2f((float)(63 - lane) * log2g);
    const float qdec = exp2f((float)(mt * 16 + fr + 1) * log2g);
    f32x4 c0, c1, s0, s1; u32x4 q1, q2, k1, k2, v1, v2;
#define RET_LOAD_RAW(cc) do { const bf16* zr_ = Zm + (size_t)(row0 + (cc) * 64 + lane) * ZM_LD + h * 128 + j0; const float* tp_ = tab + (size_t)(pos0 + (cc) * 64 + lane) * 128 + j0; \
        c0 = *(const f32x4*)tp_; c1 = *(const f32x4*)(tp_ + 4); s0 = *(const f32x4*)(tp_ + 64); s1 = *(const f32x4*)(tp_ + 68); \
        q1 = *(const u32x4*)(zr_ + 2048); q2 = *(const u32x4*)(zr_ + 2048 + 64); k1 = *(const u32x4*)(zr_ + 3072); k2 = *(const u32x4*)(zr_ + 3072 + 64); \
        v1 = *(const u32x4*)(zr_ + 4096); v2 = *(const u32x4*)(zr_ + 4096 + 64); } while (0)
    RET_LOAD_RAW(0);
    for (int c = 0; c < nchunks; ++c) {
        const int rowc = row0 + c * 64;
        {
            const float cs[8] = {c0.x, c0.y, c0.z, c0.w, c1.x, c1.y, c1.z, c1.w}, sn[8] = {s0.x, s0.y, s0.z, s0.w, s1.x, s1.y, s1.z, s1.w};
            const unsigned q1w[4] = {q1.x, q1.y, q1.z, q1.w}, q2w[4] = {q2.x, q2.y, q2.z, q2.w}, k1w[4] = {k1.x, k1.y, k1.z, k1.w}, k2w[4] = {k2.x, k2.y, k2.z, k2.w};
            const unsigned v1w[4] = {v1.x, v1.y, v1.z, v1.w}, v2w[4] = {v2.x, v2.y, v2.z, v2.w};
            float qa[8], qb[8], ka[8], kb[8];
#pragma unroll
            for (int j = 0; j < 8; ++j) {
                const float x1 = (j & 1) ? bfhi(q1w[j >> 1]) : bflo(q1w[j >> 1]), x2 = (j & 1) ? bfhi(q2w[j >> 1]) : bflo(q2w[j >> 1]);
                qa[j] = x1 * cs[j] - x2 * sn[j]; qb[j] = x1 * sn[j] + x2 * cs[j];
                const float y1 = (j & 1) ? bfhi(k1w[j >> 1]) : bflo(k1w[j >> 1]), y2 = (j & 1) ? bfhi(k2w[j >> 1]) : bflo(k2w[j >> 1]);
                ka[j] = (y1 * cs[j] - y2 * sn[j]) * 0.08838834764831845f; kb[j] = (y1 * sn[j] + y2 * cs[j]) * 0.08838834764831845f;
            }
            if constexpr (!STATE_ONLY) {
            u32x4 t;
            t.x = pk2(qa[0], qa[1]); t.y = pk2(qa[2], qa[3]); t.z = pk2(qa[4], qa[5]); t.w = pk2(qa[6], qa[7]); *(LAS u32x4*)(lds + R_QS + lane * 288 + j0 * 2) = t;
            t.x = pk2(qb[0], qb[1]); t.y = pk2(qb[2], qb[3]); t.z = pk2(qb[4], qb[5]); t.w = pk2(qb[6], qb[7]); *(LAS u32x4*)(lds + R_QS + lane * 288 + (64 + j0) * 2) = t;
            t.x = pk2(ka[0], ka[1]); t.y = pk2(ka[2], ka[3]); t.z = pk2(ka[4], ka[5]); t.w = pk2(ka[6], ka[7]); *(LAS u32x4*)(lds + R_KS + lane * 288 + j0 * 2) = t;
            t.x = pk2(kb[0], kb[1]); t.y = pk2(kb[2], kb[3]); t.z = pk2(kb[4], kb[5]); t.w = pk2(kb[6], kb[7]); *(LAS u32x4*)(lds + R_KS + lane * 288 + (64 + j0) * 2) = t;
            }
#pragma unroll
            for (int j = 0; j < 8; ++j) {
                *(LAS unsigned short*)(lds + R_KT + (j0 + j) * 160 + lane * 2) = (unsigned short)f2bf(ka[j] * kdec);
                *(LAS unsigned short*)(lds + R_KT + (64 + j0 + j) * 160 + lane * 2) = (unsigned short)f2bf(kb[j] * kdec);
                *(LAS unsigned short*)(lds + R_VT + (j0 + j) * 160 + lane * 2) = (unsigned short)((j & 1) ? (v1w[j >> 1] >> 16) : (v1w[j >> 1] & 0xffffu));
                *(LAS unsigned short*)(lds + R_VT + (64 + j0 + j) * 160 + lane * 2) = (unsigned short)((j & 1) ? (v2w[j >> 1] >> 16) : (v2w[j >> 1] & 0xffffu));
            }
            if constexpr (!STATE_ONLY) {
#pragma unroll
            for (int nt = 0; nt < 8; ++nt) { u32x2 p; p.x = pk2(S[nt][0], S[nt][1]); p.y = pk2(S[nt][2], S[nt][3]); *(LAS u32x2*)(lds + R_STB + (16 * w + fr) * 288 + (nt * 16 + 4 * fq) * 2) = p; }
            }
        }
        if (c + 1 < nchunks) RET_LOAD_RAW(c + 1);
        if constexpr (STATE_ONLY) {
            LDS_BARRIER();
            const bf16x8 av0 = *(const LAS bf16x8*)(lds + R_VT + (16 * w + fr) * 160 + (fq * 8) * 2), av1 = *(const LAS bf16x8*)(lds + R_VT + (16 * w + fr) * 160 + (32 + fq * 8) * 2);
#pragma unroll
            for (int nt = 0; nt < 8; ++nt) {
                const bf16x8 b0 = *(const LAS bf16x8*)(lds + R_KT + (nt * 16 + fr) * 160 + (fq * 8) * 2), b1 = *(const LAS bf16x8*)(lds + R_KT + (nt * 16 + fr) * 160 + (32 + fq * 8) * 2);
                S[nt] = S[nt] * cdec; S[nt] = MFMA16(b0, av0, S[nt]); S[nt] = MFMA16(b1, av1, S[nt]);
            }
            LDS_BARRIER();
            continue;
        }
        u32x2 gz[4];
#pragma unroll
        for (int t4 = 0; t4 < 4; ++t4) gz[t4] = *(const u32x2*)(Zm + (size_t)(rowc + mt * 16 + fr) * ZM_LD + 5120 + h * 128 + (wh * 4 + t4) * 16 + 4 * fq);
        LDS_BARRIER();
        bf16x8 aq[4];
#pragma unroll
        for (int kk = 0; kk < 4; ++kk) aq[kk] = *(const LAS bf16x8*)(lds + R_QS + (mt * 16 + fr) * 288 + (kk * 32 + fq * 8) * 2);
        {
#pragma unroll
            for (int t2 = 0; t2 < 2; ++t2) {
                const int nt = wh * 2 + t2; f32x4 acc = {0.f, 0.f, 0.f, 0.f};
#pragma unroll
                for (int kk = 0; kk < 4; ++kk) { const bf16x8 b = *(const LAS bf16x8*)(lds + R_KS + (nt * 16 + fr) * 288 + (kk * 32 + fq * 8) * 2); acc = MFMA16(b, aq[kk], acc); }
                const int i = mt * 16 + fr; float sv[4];
#pragma unroll
                for (int r = 0; r < 4; ++r) { const int d = i - (nt * 16 + 4 * fq + r); sv[r] = d >= 0 ? acc[r] * exp2f((float)d * log2g) : 0.f; }
                u32x2 p; p.x = pk2(sv[0], sv[1]); p.y = pk2(sv[2], sv[3]);
                *(LAS u32x2*)(lds + R_SS + i * 160 + (nt * 16 + 4 * fq) * 2) = p;
            }
        }
        LDS_BARRIER();
        f32x4 o[4];
        {
            bf16x8 as0 = *(const LAS bf16x8*)(lds + R_SS + (mt * 16 + fr) * 160 + (fq * 8) * 2), as1 = *(const LAS bf16x8*)(lds + R_SS + (mt * 16 + fr) * 160 + (32 + fq * 8) * 2);
#pragma unroll
            for (int t4 = 0; t4 < 4; ++t4) {
                const int nb = wh * 4 + t4; f32x4 ai = {0.f, 0.f, 0.f, 0.f}, ax = {0.f, 0.f, 0.f, 0.f};
                const bf16x8 bv0 = *(const LAS bf16x8*)(lds + R_VT + (nb * 16 + fr) * 160 + (fq * 8) * 2), bv1 = *(const LAS bf16x8*)(lds + R_VT + (nb * 16 + fr) * 160 + (32 + fq * 8) * 2);
                ai = MFMA16(bv0, as0, ai); ai = MFMA16(bv1, as1, ai);
#pragma unroll
                for (int kk = 0; kk < 4; ++kk) { const bf16x8 b = *(const LAS bf16x8*)(lds + R_STB + (nb * 16 + fr) * 288 + (kk * 32 + fq * 8) * 2); ax = MFMA16(b, aq[kk], ax); }
                o[t4] = ai + ax * qdec;
            }
        }
        {
            const bf16x8 av0 = *(const LAS bf16x8*)(lds + R_VT + (16 * w + fr) * 160 + (fq * 8) * 2), av1 = *(const LAS bf16x8*)(lds + R_VT + (16 * w + fr) * 160 + (32 + fq * 8) * 2);
#pragma unroll
            for (int nt = 0; nt < 8; ++nt) {
                const bf16x8 b0 = *(const LAS bf16x8*)(lds + R_KT + (nt * 16 + fr) * 160 + (fq * 8) * 2), b1 = *(const LAS bf16x8*)(lds + R_KT + (nt * 16 + fr) * 160 + (32 + fq * 8) * 2);
                S[nt] = S[nt] * cdec; S[nt] = MFMA16(b0, av0, S[nt]); S[nt] = MFMA16(b1, av1, S[nt]);
            }
        }
        {
            float s1 = 0.f, s2 = 0.f;
#pragma unroll
            for (int t4 = 0; t4 < 4; ++t4)
#pragma unroll
                for (int r = 0; r < 4; ++r) { s1 += o[t4][r]; s2 += o[t4][r] * o[t4][r]; }
            s1 += __shfl_xor(s1, 16); s1 += __shfl_xor(s1, 32); s2 += __shfl_xor(s2, 16); s2 += __shfl_xor(s2, 32);
            const int i = mt * 16 + fr;
            if (fq == 0) *(LAS f32x2*)(lds + R_GNX + (i * 2 + wh) * 8) = (f32x2){s1, s2};
            f32x4 gnG[4], gnB[4];
#pragma unroll
            for (int t4 = 0; t4 < 4; ++t4) { const int gcol = h * 128 + (wh * 4 + t4) * 16 + 4 * fq; gnG[t4] = *(const f32x4*)(gng + gcol); gnB[t4] = *(const f32x4*)(gnb + gcol); }
            LDS_BARRIER();
            const f32x2 p0 = *(const LAS f32x2*)(lds + R_GNX + (i * 2) * 8), p1 = *(const LAS f32x2*)(lds + R_GNX + (i * 2 + 1) * 8);
            const float mean = (p0.x + p1.x) * (1.f / 128.f), var = (p0.y + p1.y) * (1.f / 128.f) - mean * mean;
            const float rstd = 1.0f / sqrtf(fmaxf(var, 0.f) + 1e-5f);
            const size_t grow = (size_t)(rowc + i);
#pragma unroll
            for (int t4 = 0; t4 < 4; ++t4) {
                const int gcol = h * 128 + (wh * 4 + t4) * 16 + 4 * fq;
                const f32x4 gg = gnG[t4], gb = gnB[t4];
                const float g0 = bflo(gz[t4].x), g1 = bfhi(gz[t4].x), g2 = bflo(gz[t4].y), g3 = bfhi(gz[t4].y);
                const float y0 = ((o[t4][0] - mean) * rstd * gg.x + gb.x) * g0 * fast_sigmoid(g0);
                const float y1 = ((o[t4][1] - mean) * rstd * gg.y + gb.y) * g1 * fast_sigmoid(g1);
                const float y2 = ((o[t4][2] - mean) * rstd * gg.z + gb.z) * g2 * fast_sigmoid(g2);
                const float y3 = ((o[t4][3] - mean) * rstd * gg.w + gb.w) * g3 * fast_sigmoid(g3);
                u32x2 p; p.x = pk2(y0, y1); p.y = pk2(y2, y3);
                *(u32x2*)(Y + grow * DM + 1024 + gcol) = p;
            }
        }
    }
    if (Sout) {
#pragma unroll
        for (int nt = 0; nt < 8; ++nt)
#pragma unroll
            for (int r = 0; r < 4; ++r) Sout[(size_t)(nt * 16 + 4 * fq + r) * 128 + 16 * w + fr] = S[nt][r];
    }
#undef RET_LOAD_RAW
}

constexpr int L_GW = 0, L_WV = 18432, L_WVB = 10752, L_CAR = L_WV + 8 * L_WVB, L_RC = L_CAR + 4096;
__device__ __forceinline__ void lru_stage_gw(LAS unsigned char* lds, const bf16* rgT, const bf16* igT, int n) {
    const int tid = threadIdx.x;
#pragma unroll
    for (int i = 0; i < 2; ++i) {
        const int e = tid + i * 512, g = e >> 9, rem = e & 511, row = rem >> 3, c8 = rem & 7;
        const u32x4 v = *(const u32x4*)((g ? igT : rgT) + (size_t)n * 4096 + row * 64 + c8 * 8);
        *(LAS u32x4*)(lds + L_GW + g * 9216 + row * 144 + c8 * 16) = v;
    }
}
struct LruConst { float cw0, cw1, cw2, cw3, cb, rb, ib, cneg; };
__device__ __forceinline__ float em1(float x) {
    return x * (1.0f + x * (0.5f + x * (0.16666667f + x * (0.041666668f + x * (0.008333334f + x * (0.0013888889f + x * (0.0001984127f + x * 0.0000248016f)))))));
}
__device__ __forceinline__ f32x2 lru_local_task(LAS unsigned char* lds, const bf16* __restrict__ Zm, int row0, int n, const LruConst& K,
                                                float xm3, float xm2, float xm1, unsigned* HLA) {
    const int tid = threadIdx.x, lane = tid & 63, w = __builtin_amdgcn_readfirstlane(tid >> 6), fr = lane & 15, fq = lane >> 4;
    const int c = n * 64 + lane;
    LAS unsigned char* XC = lds + L_WV + w * L_WVB; LAS unsigned char* DG = XC + 2304;
    float A = 1.f, hl = 0.f;
#pragma unroll
    for (int mt = 0; mt < 2; ++mt) {
        float xc[16];
        const bf16* xp = Zm + (size_t)(row0 + mt * 16) * ZM_LD + c;
#pragma unroll
        for (int t = 0; t < 16; ++t) {
            const float x = bf2f(xp[t * ZM_LD]);
            xc[t] = K.cb + K.cw0 * xm3 + K.cw1 * xm2 + K.cw2 * xm1 + K.cw3 * x;
            xm3 = xm2; xm2 = xm1; xm1 = x;
            *(LAS unsigned short*)(XC + t * 144 + lane * 2) = (unsigned short)f2bf(xc[t]);
        }
        asm volatile("s_waitcnt lgkmcnt(0)" ::: "memory");
        const bf16x8 a0 = *(const LAS bf16x8*)(XC + fr * 144 + fq * 16), a1 = *(const LAS bf16x8*)(XC + fr * 144 + 64 + fq * 16);
#pragma unroll
        for (int g = 0; g < 2; ++g)
#pragma unroll
            for (int nt = 0; nt < 4; ++nt) {
                const bf16x8 b0 = *(const LAS bf16x8*)(lds + L_GW + g * 9216 + (nt * 16 + fr) * 144 + fq * 16), b1 = *(const LAS bf16x8*)(lds + L_GW + g * 9216 + (nt * 16 + fr) * 144 + 64 + fq * 16);
                f32x4 acc = {0.f, 0.f, 0.f, 0.f};
                acc = MFMA16(b0, a0, acc); acc = MFMA16(b1, a1, acc);
                *(LAS f32x4*)(DG + fr * 528 + (g * 64 + nt * 16 + 4 * fq) * 4) = acc;
            }
        asm volatile("s_waitcnt lgkmcnt(0)" ::: "memory");
        unsigned* hp = HLA + (size_t)(row0 + mt * 16) * DRNN + c;
#pragma unroll
        for (int t = 0; t < 16; ++t) {
            const float gr = *(const LAS float*)(DG + t * 528 + lane * 4), gi = *(const LAS float*)(DG + t * 528 + 256 + lane * 4);
            const float r = fast_sigmoid(gr + K.rb), ig = fast_sigmoid(gi + K.ib);
            const float la = r * K.cneg;
            const float a = 1.0f + em1(la);
            const float u = sqrtf(-em1(2.0f * la)) * ig * xc[t];
            A *= a; hl = a * hl + u;
            hp[t * DRNN] = pk2(hl, A);
        }
        asm volatile("s_waitcnt lgkmcnt(0)" ::: "memory");
    }
    return (f32x2){A, hl};
}
__device__ __forceinline__ void lru_final_task(const bf16* __restrict__ Zm, bf16* Y, const unsigned* __restrict__ HLA, const float* __restrict__ SS,
                                               const float* __restrict__ RS, int g, int n, int lane, const float* __restrict__ state_lru, float* out) {
    const int c = n * 64 + lane, row0 = g * 32;
    float hin = 0.f; float* h_out = nullptr; float* conv_out = nullptr; int r0 = 0, r1 = 0, s0;
    if (g < 256) { r0 = (g >> 6) << 3; r1 = g >> 3; s0 = g & ~7; if ((g & 63) == 63) { h_out = out + O_LRUP + (size_t)(g >> 6) * DRNN; conv_out = out + O_CONVP + (size_t)(g >> 6) * 3 * DRNN; } }
    else { const int sidx = (g - 256) >> 1; s0 = g & ~1; hin = state_lru[(size_t)sidx * DRNN + c]; if (g & 1) { h_out = out + O_LRUS + (size_t)sidx * DRNN; conv_out = out + O_CONVS + (size_t)sidx * 3 * DRNN; } }
    {
        f32x2 p[8];
#pragma unroll
        for (int u = 0; u < 8; ++u) p[u] = (r0 + u < r1) ? *(const f32x2*)(RS + ((size_t)(r0 + u) * DRNN + c) * 2) : (f32x2){1.f, 0.f};
#pragma unroll
        for (int u = 0; u < 8; ++u) hin = p[u].x * hin + p[u].y;
#pragma unroll
        for (int u = 0; u < 8; ++u) p[u] = (s0 + u < g) ? *(const f32x2*)(SS + ((size_t)(s0 + u) * DRNN + c) * 2) : (f32x2){1.f, 0.f};
#pragma unroll
        for (int u = 0; u < 8; ++u) hin = p[u].x * hin + p[u].y;
    }
    float hv = 0.f;
#pragma unroll
    for (int tg = 0; tg < 4; ++tg) {
        const size_t r = (size_t)(row0 + tg * 8);
        float hl[8], ac[8], gav[8];
#pragma unroll
        for (int t = 0; t < 8; ++t) { const unsigned w = HLA[(r + t) * DRNN + c]; hl[t] = bflo(w); ac[t] = bfhi(w); gav[t] = bf2f(Zm[(r + t) * ZM_LD + 1024 + c]); }
#pragma unroll
        for (int t = 0; t < 8; ++t) {
            hv = hl[t] + ac[t] * hin; const float ga = gav[t];
            const float y = hv * ga * fast_sigmoid(1.5957691216057308f * (ga + 0.044715f * ga * ga * ga));
            Y[(r + t) * DM + c] = (bf16)f2bf(y);
        }
        asm volatile("" ::: "memory");
    }
    if (h_out) { h_out[c] = hv; conv_out[c] = bf2f(Zm[(size_t)(row0 + 29) * ZM_LD + c]); conv_out[1024 + c] = bf2f(Zm[(size_t)(row0 + 30) * ZM_LD + c]); conv_out[2048 + c] = bf2f(Zm[(size_t)(row0 + 31) * ZM_LD + c]); }
}
__device__ __forceinline__ LruConst lru_consts(const float* cw, const float* cb, const float* rgb, const float* igb, const float* lam, int c) {
    LruConst K; K.cw0 = cw[c]; K.cw1 = cw[1024 + c]; K.cw2 = cw[2048 + c]; K.cw3 = cw[3072 + c]; K.cb = cb[c]; K.rb = rgb[c]; K.ib = igb[c];
    const float l = lam[c];
    K.cneg = -8.0f * log1pf(expf(-l));
    return K;
}

#define XB_TMO      128
#define XB_XCNT(j)  (256  + 64 * (j))
#define XB_XSUB(j)  (1280 + 64 * (j))
#define XB_XGEN(j)  (2304 + 64 * (j))
#define XB_TOP      3328
#define XB_TOPGEN   3392
#define XCD_BAR_WORDS 3456
#define XB_SPIN_CAP (1u << 18)

__device__ __forceinline__ unsigned xb_ld(unsigned* p)              { return __hip_atomic_load(p, __ATOMIC_RELAXED, __HIP_MEMORY_SCOPE_AGENT); }
__device__ __forceinline__ unsigned xb_add(unsigned* p, unsigned v) { return __hip_atomic_fetch_add(p, v, __ATOMIC_RELAXED, __HIP_MEMORY_SCOPE_AGENT); }
__device__ __forceinline__ unsigned xb_xcc_id() { return (unsigned)__builtin_amdgcn_s_getreg((3 << 11) | 20) & 0xFu; }
#define XB_SPIN(cond, bar) do { unsigned _sp = 0; while (cond) { __builtin_amdgcn_s_sleep(1); \
    if ((++_sp & 255u) == 0u) { if (xb_ld(&(bar)[XB_TMO])) break; if (_sp > XB_SPIN_CAP) { atomicAdd(&(bar)[XB_TMO], 1u); break; } } } } while (0)

struct XcdBarrier {
    unsigned* bar; unsigned x;
    volatile LAS unsigned* st;
};

__device__ __forceinline__ XcdBarrier xcd_barrier_post(unsigned* bar, volatile LAS unsigned* st) {
    XcdBarrier b; b.bar = bar; b.x = xb_xcc_id(); b.st = st;
    if (threadIdx.x == 0) (void)xb_add(&bar[XB_XCNT(b.x)], 1u);
    return b;
}
__device__ __forceinline__ void xcd_barrier_complete(unsigned* bar, unsigned x, unsigned& nloc, unsigned& nx) {
    const unsigned G = gridDim.x * gridDim.y * gridDim.z;
    unsigned sum, cnt, mine, sp = 0u;
    for (;;) {
        sum = 0u; cnt = 0u; mine = 0u;
#pragma unroll
        for (unsigned j = 0; j < 16; ++j) { const unsigned c = xb_ld(&bar[XB_XCNT(j)]); sum += c; cnt += (c > 0u) ? 1u : 0u; mine = (j == x) ? c : mine; }
        if (sum == G) break;
        __builtin_amdgcn_s_sleep(1);
        if ((++sp & 255u) == 0u) { if (xb_ld(&bar[XB_TMO])) break; if (sp > XB_SPIN_CAP) { atomicAdd(&bar[XB_TMO], 1u); break; } }
    }
    nloc = mine > 0u ? mine : 1u; nx = cnt > 0u ? cnt : 1u;
}

__device__ __forceinline__ void xcd_barrier(const XcdBarrier& b) {
    asm volatile("s_waitcnt vmcnt(0)" ::: "memory");
    __syncthreads();
    if (threadIdx.x == 0) {
        unsigned* bar = b.bar;
        __builtin_amdgcn_s_waitcnt(0);
        unsigned nloc = b.st[0], nx = b.st[1];
        if (nloc == 0u) { xcd_barrier_complete(bar, b.x, nloc, nx); b.st[0] = nloc; b.st[1] = nx; }
        const unsigned old = xb_add(&bar[XB_XSUB(b.x)], 1u);
        const unsigned gen = old / nloc;
        if (old + 1u == (gen + 1u) * nloc) {
            __builtin_amdgcn_fence(__ATOMIC_RELEASE, "agent");
            asm volatile("s_waitcnt vmcnt(0)" ::: "memory");
            const unsigned og = xb_add(&bar[XB_TOP], 1u);
            const unsigned tg = og / nx;
            if (og + 1u == (tg + 1u) * nx) xb_add(&bar[XB_TOPGEN], 1u);
            else XB_SPIN(xb_ld(&bar[XB_TOPGEN]) == tg, bar);
            __builtin_amdgcn_fence(__ATOMIC_ACQUIRE, "agent");
            xb_add(&bar[XB_XGEN(b.x)], 1u);
            asm volatile("s_waitcnt vmcnt(0)" ::: "memory");
        } else {
            XB_SPIN(xb_ld(&bar[XB_XGEN(b.x)]) == gen, bar);
            __builtin_amdgcn_fence(__ATOMIC_ACQUIRE, "agent");
            asm volatile("s_waitcnt vmcnt(0)" ::: "memory");
        }
    }
    __syncthreads();
}

struct Args { const float* in[30]; float* out; unsigned char* ws; };
static_assert(sizeof(Args) == 32 * 8, "Args has no padding");

__global__ void __launch_bounds__(NTHREADS, 2) fwd_megakernel(Args a) {
    extern __shared__ __attribute__((aligned(16))) unsigned char lds_raw[];
    LAS unsigned char* lds = (LAS unsigned char*)lds_raw;
    cg::grid_group grid = cg::this_grid();
    if (threadIdx.x < 8) ((volatile LAS unsigned*)(lds + 131072))[threadIdx.x] = 0u;
    __syncthreads();
    if (blockIdx.x == 0) for (int i = threadIdx.x; i < 4096; i += NTHREADS) ((unsigned*)a.ws)[i] = 0u;
    const int tid = threadIdx.x, lane = tid & 63, wave = __builtin_amdgcn_readfirstlane(tid >> 6);
    const int G = gridDim.x, blk = blockIdx.x;
    const int gw = blk * NWAVES + wave, ngw = G * NWAVES;
    const int vcu = (G % 8 == 0) ? (blk % 8) * (G / 8) + blk / 8 : blk;
    unsigned char* ws = a.ws;
    float* tab = (float*)(ws + WS_TAB);
    float* ST1 = (float*)(ws + WS_TAB + 1081344); float* ST2 = ST1 + (size_t)MT * 2;
    bf16* rgT = (bf16*)(ws + WS_GATEW); bf16* igT = rgT + 16 * 4096;
    bf16* Wgu = (bf16*)(ws + WS_WGU); bf16* Wd = (bf16*)(ws + WS_WD); bf16* Win = (bf16*)(ws + WS_WIN); bf16* Wab = (bf16*)(ws + WS_WAB); bf16* Wo = (bf16*)(ws + WS_WO);
    bf16* XNB = (bf16*)(ws + WS_XNB); float* X1 = (float*)(ws + WS_X1); bf16* Hb = (bf16*)(ws + WS_H); bf16* Zm = (bf16*)(ws + WS_H); bf16* MG = (bf16*)(ws + WS_H);
    float* T = (float*)(ws + WS_T); bf16* Zg = (bf16*)(ws + WS_T);
    LAS float* scr = (LAS float*)(lds + wave * 8448);

    conv_mat(a.in[5], DM, DFF, Wgu, DM, 0, 1, gw, ngw, scr, lane);
    conv_mat(a.in[6], DM, DFF, Wgu, DM, 0, 2, gw, ngw, scr, lane);
    conv_mat(a.in[10], DM, 10240, Win, DM, 0, 0, gw, ngw, scr, lane);
    for (int it = gw; it < 64; it += ngw) {
        const int g = it >> 5, n = (it >> 1) & 15, nh = it & 1;
        tr_item(a.in[g ? 15 : 13] + (size_t)n * 4096, 64, 0, nh * 32, (g ? igT : rgT) + (size_t)n * 4096, (size_t)nh * 32, 64, 0, scr, lane);
    }
    {
        const size_t n8 = (size_t)MT * DM / 8, np8 = (size_t)MP * DM / 8;
        const size_t gstr = (size_t)G * NTHREADS;
        for (size_t i0 = (size_t)blk * NTHREADS + tid; i0 < n8; i0 += 4 * gstr) {
            f32x4 v0[4], v1[4];
#pragma unroll
            for (int u = 0; u < 4; ++u) { const size_t i = i0 + u * gstr; if (i < n8) { const float* src = i < np8 ? a.in[0] + i * 8 : a.in[1] + (i - np8) * 8; v0[u] = *(const f32x4*)src; v1[u] = *(const f32x4*)(src + 4); } }
#pragma unroll
            for (int u = 0; u < 4; ++u) { const size_t i = i0 + u * gstr; if (i < n8) { u32x4 w; w.x = pk2(v0[u].x, v0[u].y); w.y = pk2(v0[u].z, v0[u].w); w.z = pk2(v1[u].x, v1[u].y); w.w = pk2(v1[u].z, v1[u].w); *(u32x4*)(XNB + i * 8) = w; } }
        }
        for (int i = blk * NTHREADS + tid; i < NPOS * 64; i += G * NTHREADS) {
            const int p = i >> 6, j = i & 63;
            const float invf = exp2f(-(float)(2 * j) * (13.287712379549449f / 128.0f));
            double rev = (double)p * (double)invf * 0.15915494309189535; rev -= floor(rev);
            const float rf = (float)rev;
            tab[(size_t)p * 128 + j] = __builtin_amdgcn_cosf(rf); tab[(size_t)p * 128 + 64 + j] = __builtin_amdgcn_sinf(rf);
        }
    }
    grid.sync();
    const XcdBarrier xbar = xcd_barrier_post((unsigned*)a.ws, (volatile LAS unsigned*)(lds + 131072));

    { pg8::Gemm g{XNB, Wgu, MT, 2 * DFF, DM}; pg8::StaticOrder S; S.init(MT, 2 * DFF, G, blk, DM); EpiSwiglu E{Hb};
      pg8::gemm_phase<EpiSwiglu, pg8::StaticOrder, true, true>(lds, g, S, E); }
    {
        const int nbusy = (40 * 44) % G; int cgw = gw, cngw = ngw;
        if (nbusy != 0) { cgw = blk >= nbusy ? (blk - nbusy) * NWAVES + wave : -1; cngw = (G - nbusy) * NWAVES; }
        if (cgw >= 0) conv_mat(a.in[7], DFF, DM, Wd, DFF, 0, 0, cgw, cngw, scr, lane);
    }
    xcd_barrier(xbar);
    { pg8::TailSplitOrder SKd; { int G2 = G; asm volatile("" : "+s"(G2)); SKd.init(MT, DM, DFF, G2, vcu); } pg8::Gemm g{Hb, Wd, MT, DM, DFF}; EpiRes<false, true> E; E.RB = XNB; E.T = (bf16*)X1;     E.P = (bf16*)a.out; E.st = ST1; E.lg = a.in[8]; E.lb = a.in[9];
      pg8::gemm_phase<EpiRes<false, true>, pg8::TailSplitOrder, true, true>(lds, g, SKd, E); }
    xcd_barrier(xbar);
    { pg8::TailSplitOrder SKd; { int G2 = G; asm volatile("" : "+s"(G2)); SKd.init(MT, DM, DFF, G2, vcu); } ln_rows((bf16*)X1, (const bf16*)a.out, SKd.tail_pm0(), SKd.split - 1, a.in[8], a.in[9], nullptr, XNB, ST1, gw, ngw, lane); }
    xcd_barrier(xbar);
    { pg8::Gemm g{XNB, Win, MT, 10240, DM}; pg8::StaticOrder S; S.init(MT, 10240, G, blk, DM); EpiZ E{Zm, Zg};
      pg8::gemm_phase<EpiZ, pg8::StaticOrder, true, true>(lds, g, S, E); }
    {
        const int nbusy = (40 * 40) % G; int cgw = gw, cngw = ngw;
        if (nbusy != 0) { cgw = blk >= nbusy ? (blk - nbusy) * NWAVES + wave : -1; cngw = (G - nbusy) * NWAVES; }
        if (cgw >= 0) {
            conv_mat(a.in[20], DRNN, DM, Wab, DM, 0, 0, cgw, cngw, scr, lane);
            conv_mat(a.in[21], DRNN, DM, Wab, DM, 1024, 0, cgw, cngw, scr, lane);
            conv_mat(a.in[22], DM, DM, Wo, DM, 0, 0, cgw, cngw, scr, lane);
        }
    }
    xcd_barrier(xbar);
    {
        bf16* Y = XNB;
        const float* gng = a.in[18]; const float* gnb = a.in[19];
        unsigned* HLA = (unsigned*)(ws + WS_WGU);
        float* SLOC = (float*)(HLA + (size_t)MT * DRNN);
        float* SSUM = SLOC + (size_t)NB * NHEAD * 8 * 16384;
        float* RSUM = SSUM + (size_t)320 * DRNN * 2;
        int staged_n = -1; LruConst K = {};
        for (int i = blk; i < 640 + 224; i += G) {
            if (i < 640) {
                const int n = i & 15, sg = i >> 4, g = sg * 8 + wave, row0 = g * 32, c = n * 64 + lane;
                __syncthreads();
                if (n != staged_n) {
                    lru_stage_gw(lds, rgT, igT, n);
                    K = lru_consts(a.in[11], a.in[12], a.in[14], a.in[16], a.in[17], c);
                    staged_n = n;
                    __syncthreads();
                }
                float xm3 = 0.f, xm2 = 0.f, xm1 = 0.f;
                const bool first = g < 256 ? ((g & 63) == 0) : ((g & 1) == 0);
                if (!first) { xm3 = bf2f(Zm[(size_t)(row0 - 3) * ZM_LD + c]); xm2 = bf2f(Zm[(size_t)(row0 - 2) * ZM_LD + c]); xm1 = bf2f(Zm[(size_t)(row0 - 1) * ZM_LD + c]); }
                else if (g >= 256) { const float* sc = a.in[2] + (size_t)((g - 256) >> 1) * 3 * DRNN; xm3 = sc[c]; xm2 = sc[1024 + c]; xm1 = sc[2048 + c]; }
                const f32x2 sm = lru_local_task(lds, Zm, row0, n, K, xm3, xm2, xm1, HLA);
                *(f32x2*)(SSUM + ((size_t)g * DRNN + c) * 2) = sm;
                *(LAS f32x2*)(lds + L_CAR + (wave * 64 + lane) * 8) = sm;
                __syncthreads();
                if (wave == 0) {
                    float Ar = 1.f, hr = 0.f;
#pragma unroll
                    for (int w2 = 0; w2 < 8; ++w2) { const f32x2 p = *(const LAS f32x2*)(lds + L_CAR + (w2 * 64 + lane) * 8); hr = p.x * hr + p.y; Ar *= p.x; }
                    *(f32x2*)(RSUM + ((size_t)sg * DRNN + c) * 2) = (f32x2){Ar, hr};
                }
            } else {
                const int j = i - 640, bh = j / 7, sgm = j - bh * 7;
                __syncthreads();
                staged_n = -1;
                ret_item<true>(lds, Zm, (bh >> 3) * SEQ + sgm * 256, 4, sgm * 256, bh & 7, nullptr, 0, 0.f, SLOC + (size_t)(bh * 8 + sgm) * 16384, tab, gng, gnb, Y);
            }
        }
        xcd_barrier(xbar);
        for (int i = blk; i < 512; i += G) {
            __syncthreads();
            if (i < 256) {
                const int bh = i >> 3, sgm = i & 7, h = bh & 7;
                const float fdec = exp2f(256.0f * log2f(1.0f - exp2f(-5.0f - (float)h)));
                ret_item<false>(lds, Zm, (bh >> 3) * SEQ + sgm * 256, 4, sgm * 256, h, SLOC + (size_t)(bh * 8) * 16384, sgm, fdec,
                                sgm == 7 ? a.out + O_RETP + (size_t)bh * 16384 : nullptr, tab, gng, gnb, Y);
            } else {
                const int j = i - 256, sidx = j >> 3, h = j & 7;
                ret_item<false>(lds, Zm, MP + sidx * DSEQ, 1, SEQ, h, a.in[4] + (size_t)j * 16384, 1, 0.f, a.out + O_RETS + (size_t)j * 16384, tab, gng, gnb, Y);
            }
        }
        for (int wt = gw; wt < 320 * 16; wt += ngw) lru_final_task(Zm, Y, HLA, SSUM, RSUM, wt >> 4, wt & 15, lane, a.in[3], a.out);
    }
    xcd_barrier(xbar);
    { pg8::Gemm g{XNB, Wab, MT, DM, DM}; pg8::StaticOrder S; S.init(MT, DM, G, blk, DM); EpiMerge E{Zg, MG};
      pg8::gemm_phase<EpiMerge, pg8::StaticOrder, true, true>(lds, g, S, E); }
    {
        const int nbusy = (40 * 8) % G; int cgw = gw, cngw = ngw;
        if (nbusy != 0) { cgw = blk >= nbusy ? (blk - nbusy) * NWAVES + wave : -1; cngw = (G - nbusy) * NWAVES; }
        if (cgw >= 0) {
            conv_mat(a.in[25], DM, DFF, Wgu, DM, 0, 1, cgw, cngw, scr, lane);
            conv_mat(a.in[26], DM, DFF, Wgu, DM, 0, 2, cgw, cngw, scr, lane);
            conv_mat(a.in[27], DFF, DM, Wd, DFF, 0, 0, cgw, cngw, scr, lane);
        }
    }
    xcd_barrier(xbar);
    { pg8::TailSplitOrder SKo; { int G2 = G; asm volatile("" : "+s"(G2)); SKo.init(MT, DM, DM, G2, vcu); } pg8::Gemm g{MG, Wo, MT, DM, DM}; EpiRes<true, false> E; E.RB = (const bf16*)X1; E.T = (bf16*)X1; E.P = (bf16*)a.out; E.st = ST1; E.lg = a.in[8]; E.lb = a.in[9];
      pg8::gemm_phase<EpiRes<true, false>, pg8::TailSplitOrder, true, true>(lds, g, SKo, E); }
    xcd_barrier(xbar);
    { pg8::TailSplitOrder SKo; { int G2 = G; asm volatile("" : "+s"(G2)); SKo.init(MT, DM, DM, G2, vcu); } ln_rows((bf16*)X1, (const bf16*)a.out, SKo.tail_pm0(), SKo.split - 1, a.in[23], a.in[24], nullptr, XNB, ST2, gw, ngw, lane); }
    xcd_barrier(xbar);
    { pg8::Gemm g{XNB, Wgu, MT, 2 * DFF, DM}; pg8::StaticOrder S; S.init(MT, 2 * DFF, G, blk, DM); EpiSwiglu E{Hb};
      pg8::gemm_phase<EpiSwiglu, pg8::StaticOrder, true, true>(lds, g, S, E); }
    xcd_barrier(xbar);
    { pg8::TailSplitOrder SKd; { int G2 = G; asm volatile("" : "+s"(G2)); SKd.init(MT, DM, DFF, G2, vcu); } pg8::Gemm g{Hb, Wd, MT, DM, DFF}; EpiRes<true, true> E; E.RB = (const bf16*)X1; E.T = (bf16*)T; E.P = (bf16*)(ws + WS_WIN); E.st = ST2; E.lg = a.in[23]; E.lb = a.in[24];
      pg8::gemm_phase<EpiRes<true, true>, pg8::TailSplitOrder, true, true>(lds, g, SKd, E); }
    xcd_barrier(xbar);
    { pg8::TailSplitOrder SKd; { int G2 = G; asm volatile("" : "+s"(G2)); SKd.init(MT, DM, DFF, G2, vcu); } ln_rows((bf16*)T, (const bf16*)(ws + WS_WIN), SKd.tail_pm0(), SKd.split - 1, a.in[28], a.in[29], a.out + O_Y, nullptr, nullptr, gw, ngw, lane); }
}

extern "C" void kernel_launch(void* const* d_in, const int* in_sizes, int n_in, void* d_out, int out_size, void* d_ws, size_t ws_size, hipStream_t stream) {
    static int grid = 0;
    if (grid == 0) {
        if (n_in != 30 || ws_size < WS_END) { fprintf(stderr, "kernel_launch: unexpected n_in %d or ws_size %zu (need %zu)\n", n_in, ws_size, (size_t)WS_END); grid = -1; return; }
        int dev = 0, cus = 0, per_cu = 0;
        hipGetDevice(&dev);
        hipDeviceGetAttribute(&cus, hipDeviceAttributeMultiprocessorCount, dev);
        if (hipFuncSetAttribute((const void*)fwd_megakernel, hipFuncAttributeMaxDynamicSharedMemorySize, LDS_BYTES) != hipSuccess) { fprintf(stderr, "kernel_launch: hipFuncSetAttribute failed\n"); grid = -1; return; }
        if (hipOccupancyMaxActiveBlocksPerMultiprocessor(&per_cu, (const void*)fwd_megakernel, NTHREADS, LDS_BYTES) != hipSuccess || per_cu < 1) { fprintf(stderr, "kernel_launch: occupancy query says %d\n", per_cu); per_cu = 1; }
        (void)hipGetLastError();
        grid = cus;
    }
    if (grid < 0) return;
    Args a{};
    for (int i = 0; i < 30; ++i) a.in[i] = (const float*)d_in[i];
    a.out = (float*)d_out; a.ws = (unsigned char*)d_ws;
    void* args[] = {&a};
    hipError_t e = hipLaunchCooperativeKernel((const void*)fwd_megakernel, dim3(grid), dim3(NTHREADS), args, LDS_BYTES, stream);
    if (e != hipSuccess) fprintf(stderr, "kernel_launch: cooperative launch failed: %s (grid %d)\n", hipGetErrorString(e), grid);
}
```
